# Optimizing an MI355X kernel written in HIP

```python
import jax, jax.numpy as jnp
from jax import lax
import numpy as np

D_MODEL = 2048
BATCH = 1
SEQ = 8192
DEPTH = 1
DEC_BATCH = 2
DEC_SEQ = 8192
PAST_LEN = 128

GRID_W = 64
N_HEADS = D_MODEL // 128
HEAD_DIM = 64
ATT_WIDTH = N_HEADS * HEAD_DIM
N_FGROUPS = 4
FGROUP_DIM = D_MODEL // 8
FOURIER_WIDTH = N_FGROUPS * FGROUP_DIM
WIN_ROWS_MAX = 8
WIN_COLS = 16
D_FF = 4 * D_MODEL
IN_WIDTH = 3 * ATT_WIDTH + FOURIER_WIDTH + 2 * D_MODEL
EPS = 1e-6

kernel_name = 'hybrid_fnet_natten_encoder'


def rmsnorm(x, g):
    xf = x.astype(jnp.float32)
    y = xf * lax.rsqrt(jnp.mean(xf * xf, axis=-1, keepdims=True) + EPS)
    return (y * g.astype(jnp.float32)).astype(x.dtype)


def fourier_mix(f):
    B, S, _ = f.shape
    u = f.astype(jnp.float32).reshape(B, S, N_FGROUPS, FGROUP_DIM)
    y = jnp.fft.fft2(u, axes=(1, 3), norm='ortho').real
    return y.reshape(B, S, FOURIER_WIDTH).astype(f.dtype)


def neighbourhood_attention(q, k, v, rpb):
    B, S, H, Dh = q.shape
    rows = S // GRID_W
    kr = min(WIN_ROWS_MAX, rows)
    qg = q.reshape(B, rows, GRID_W, H, Dh)
    kg = k.reshape(B, rows, GRID_W, H, Dh)
    vg = v.reshape(B, rows, GRID_W, H, Dh)
    cols = jnp.arange(GRID_W)
    cstart = jnp.clip(cols - WIN_COLS // 2, 0, GRID_W - WIN_COLS)
    col_idx = cstart[:, None] + jnp.arange(WIN_COLS)[None, :]
    coff = col_idx - cols[:, None] + (WIN_COLS - 1)
    scale = HEAD_DIM ** -0.5

    def one_row(r):
        rstart = jnp.clip(r - kr // 2, 0, rows - kr)
        kb = lax.dynamic_slice_in_dim(kg, rstart, kr, axis=1)
        vb = lax.dynamic_slice_in_dim(vg, rstart, kr, axis=1)
        qr = lax.dynamic_index_in_dim(qg, r, axis=1, keepdims=False)
        kw = kb[:, :, col_idx]
        vw = vb[:, :, col_idx]
        roff = rstart + jnp.arange(kr) - r + (WIN_ROWS_MAX - 1)
        bias = rpb[:, roff[None, :, None], coff[:, None, :]]
        s = jnp.einsum('bwhd,bawchd->bhwac', qr, kw).astype(jnp.float32) * scale
        s = s + bias.astype(jnp.float32)[None]
        p = jax.nn.softmax(s.reshape(B, H, GRID_W, kr * WIN_COLS), axis=-1)
        p = p.reshape(s.shape).astype(v.dtype)
        return jnp.einsum('bhwac,bawchd->bwhd', p, vw)

    out = lax.map(one_row, jnp.arange(rows))
    return jnp.transpose(out, (1, 0, 2, 3, 4)).reshape(B, S, H * Dh)


def encoder_block(x, g_mix, w_in, q_norm, k_norm, rpb, w_fo, w_ao, w_out, g_mlp, w1, w2):
    B, S, _ = x.shape
    h = rmsnorm(x, g_mix)
    z = h @ w_in
    a0 = ATT_WIDTH
    f0 = 3 * ATT_WIDTH
    g0 = f0 + FOURIER_WIDTH
    q, k, v, f, ga, gb = jnp.split(z, [a0, 2 * a0, f0, g0, g0 + D_MODEL], axis=-1)
    q = rmsnorm(q.reshape(B, S, N_HEADS, HEAD_DIM), q_norm)
    k = rmsnorm(k.reshape(B, S, N_HEADS, HEAD_DIM), k_norm)
    v = v.reshape(B, S, N_HEADS, HEAD_DIM)
    ya = fourier_mix(f) @ w_fo
    yb = neighbourhood_attention(q, k, v, rpb) @ w_ao
    merged = jax.nn.sigmoid(ga) * ya + jax.nn.sigmoid(gb) * yb
    x = x + merged @ w_out
    u = jnp.maximum(rmsnorm(x, g_mlp) @ w1, 0)
    return x + (u * u) @ w2


def setup_inputs(seed: int = 0) -> dict:
    key = jax.random.key(seed)
    ks = jax.random.split(key, 14)
    def w(k, shape, fan_in):
        return jax.random.normal(k, shape, jnp.float32) * fan_in ** -0.5
    def gain(k, shape):
        return 1.0 + 0.01 * jax.random.normal(k, shape, jnp.float32)
    return {
        'x_prompt': jax.random.normal(ks[0], (BATCH, SEQ, D_MODEL), jnp.float32),
        'x_sample': jax.random.normal(ks[1], (DEC_BATCH, DEC_SEQ, D_MODEL), jnp.float32),
        'g_mix': gain(ks[2], (DEPTH, D_MODEL)),
        'w_in': w(ks[3], (DEPTH, D_MODEL, IN_WIDTH), D_MODEL),
        'q_norm': gain(ks[4], (DEPTH, HEAD_DIM)),
        'k_norm': gain(ks[5], (DEPTH, HEAD_DIM)),
        'rpb': 0.1 * jax.random.normal(ks[6], (DEPTH, N_HEADS, 2 * WIN_ROWS_MAX - 1, 2 * WIN_COLS - 1), jnp.float32),
        'w_fo': w(ks[7], (DEPTH, FOURIER_WIDTH, D_MODEL), FOURIER_WIDTH),
        'w_ao': w(ks[8], (DEPTH, ATT_WIDTH, D_MODEL), ATT_WIDTH),
        'w_out': w(ks[9], (DEPTH, D_MODEL, D_MODEL), D_MODEL),
        'g_mlp': gain(ks[10], (DEPTH, D_MODEL)),
        'w1': w(ks[11], (DEPTH, D_MODEL, D_FF), D_MODEL),
        'w2': w(ks[12], (DEPTH, D_FF, D_MODEL), D_FF),
    }


def reference(x_prompt, x_sample, g_mix, w_in, q_norm, k_norm, rpb, w_fo, w_ao, w_out, g_mlp, w1, w2):
    y_prompt = x_prompt
    y_sample = x_sample
    for l in range(DEPTH):
        params = (g_mix[l], w_in[l], q_norm[l], k_norm[l], rpb[l], w_fo[l], w_ao[l], w_out[l], g_mlp[l], w1[l], w2[l])
        y_prompt = encoder_block(y_prompt, *params)
        y_sample = encoder_block(y_sample, *params)
    return (y_prompt, y_sample)
```

```cpp
#include <hip/hip_runtime.h>
#include <cstdio>
#include <cstdint>

typedef unsigned short bf16_t;
typedef short bf16x8 __attribute__((ext_vector_type(8)));
typedef short s16x4 __attribute__((ext_vector_type(4)));
typedef float f32x2 __attribute__((ext_vector_type(2)));
typedef float f32x4 __attribute__((ext_vector_type(4)));
typedef float f32x16 __attribute__((ext_vector_type(16)));
typedef unsigned u32x2 __attribute__((ext_vector_type(2)));
typedef unsigned u32x4 __attribute__((ext_vector_type(4)));
#define LAS __attribute__((address_space(3)))
#define GAS __attribute__((address_space(1)))

constexpr int D = 2048, SEQ = 8192, NB = 3, M = NB * SEQ;
constexpr int NH = 16, HD = 64, AW = 1024, FW = 1024, INW = 8192, DFF = 8192;
constexpr float EPS = 1e-6f;
constexpr float LOG2E = 1.4426950408889634f;
constexpr float QSCALE = 0.125f * LOG2E;
constexpr float S_ORTHO = 6.905339660024878e-4f;

constexpr size_t MiB = 1u << 20;
constexpr size_t WS_CTL = 0, CTL_ZERO_BYTES = 65536;
constexpr size_t WS_TAB = 1 * MiB;
constexpr size_t T_RSTD1 = WS_TAB, T_RSTD2 = WS_TAB + 98304;
constexpr size_t T_DFTC = WS_TAB + 196608, T_DFTS = WS_TAB + 327680;
constexpr size_t T_F128C = WS_TAB + 458752, T_F128S = WS_TAB + 491520;
constexpr size_t T_F64 = WS_TAB + 524288;
constexpr size_t T_RPB = WS_TAB + 557056;
constexpr size_t T_TW = WS_TAB + 589824;
constexpr size_t T_CS = WS_TAB + 1048576;
constexpr size_t T_P4096 = WS_TAB + 1048576 + 524288;
constexpr size_t WS_SSQ = 3 * MiB;
constexpr size_t WS_WIN = 6 * MiB, WS_WFO = 38 * MiB, WS_WAO = 42 * MiB, WS_WOUT = 54 * MiB, WS_W1 = 62 * MiB, WS_W2 = 94 * MiB;
constexpr size_t WS_B = 126 * MiB, WS_Q = WS_B, WS_K = WS_B + 48 * MiB, WS_V = WS_B + 96 * MiB, WS_MERGED = WS_B;
constexpr size_t WS_A = 270 * MiB, WS_XB = WS_A, WS_PT = WS_A;
constexpr size_t WS_C = 366 * MiB, WS_FT = WS_C, WS_FM = WS_C;
constexpr size_t WS_D = 414 * MiB, WS_ATT = WS_D, WS_X1B = WS_D;
constexpr size_t WS_U = 126 * MiB;
constexpr size_t WS_TMP0 = 6 * MiB, WS_TMP1 = 318 * MiB;
constexpr size_t WS_END = 510 * MiB;
constexpr int ATT_LD = 1024;
constexpr size_t WS_Y = 366 * MiB;

__device__ __forceinline__ float bf2f(bf16_t v) { return __uint_as_float((unsigned)v << 16); }
__device__ __forceinline__ bf16_t f2bf(float f) { unsigned u = __float_as_uint(f); return (bf16_t)((u + 0x7fffu + ((u >> 16) & 1u)) >> 16); }
__device__ __forceinline__ unsigned pk2(float lo, float hi) { return (unsigned)f2bf(lo) | ((unsigned)f2bf(hi) << 16); }

struct XIn { const float* xp; const float* xs; __device__ __forceinline__ const float* row(int m) const { return m < SEQ ? xp + (size_t)m * D : xs + (size_t)(m - SEQ) * D; } };

namespace g8 {
constexpr int BM = 256, BK = 64, HALF = 128, HTB = HALF * BK * 2, STAGE_BYTES = 8 * HTB, NXCD = 8, WGM = 4;

__host__ __device__ __forceinline__ int lds_byte(int r, int c) { const int st = (r >> 4) * 2 + (c >> 5), rr = r & 15, cc = c & 31, ob = rr * 64 + cc * 2; return st * 1024 + (ob ^ (((ob >> 9) & 1) << 5)); }
__host__ __device__ __forceinline__ void stage_rc(int b, int& R, int& C) { const int st = b / 1024, sb = b % 1024, swz = sb ^ (((sb >> 9) & 1) << 5); R = (st >> 1) * 16 + swz / 64; C = (st & 1) * 32 + (swz % 64) / 2; }
__host__ __device__ __forceinline__ int perm32(int rho) { const int n = rho >> 4, i = rho & 15; return 8 * (i >> 2) + 4 * n + (i & 3); }

struct Unit { const char* a; const char* b; int pm, pn, nt, keep, br; };

template <int WG = WGM> __device__ __forceinline__ void tile_of(int L, int nM, int nN, int& pm, int& pn) {
    const int nwg = nM * nN; int wgid = L;
    { const int q = nwg / NXCD, r = nwg % NXCD, xcd = wgid % NXCD, off = wgid / NXCD; wgid = (xcd < r ? xcd * (q + 1) : r * (q + 1) + (xcd - r) * q) + off; }
    const int nig = WG * nN, gid = wgid / nig, fm = gid * WG, gsz = (nM - fm) < WG ? (nM - fm) : WG;
    pm = fm + ((wgid % nig) % gsz); pn = (wgid % nig) / gsz;
}

typedef __bf16 bf16x2_t __attribute__((ext_vector_type(2)));
__device__ __forceinline__ unsigned cvt_pk_bf16(float lo, float hi) { f32x2 v = {lo, hi}; bf16x2_t b = __builtin_convertvector(v, bf16x2_t); return __builtin_bit_cast(unsigned, b); }

template <bool HEAD64> __device__ __forceinline__ int colbase(int bj, int wc, int fq) { return HEAD64 ? (64 * wc + 32 * bj + 8 * fq) : (128 * bj + 32 * wc + 8 * fq); }

template <class Epi, class Sched, int lda, int ldb, bool HEAD64, int KREP = 1, bool AKM = false>
__device__ __forceinline__ void gemm_phase(LAS unsigned char* lds, const Sched& S, const Epi& E) {
    const int tid = threadIdx.x, wid = __builtin_amdgcn_readfirstlane(tid >> 6), lane = tid & 63, wr = wid >> 2, wc = wid & 3, fr = lane & 15, fq = lane >> 4;
    Unit cur, nxt; int ui = 0; bool prev_keep = false;
    if (!S.next(0, cur)) return;
    unsigned voffB[2], voffA[2];
#pragma unroll
    for (int i = 0; i < 2; ++i) { int R, C; stage_rc(tid * 16 + i * 8192, R, C);
        const int Rb = HEAD64 ? ((R >> 5) * 64 + perm32(R & 31)) : ((R & ~31) + perm32(R & 31));
        voffB[i] = (unsigned)(Rb * ldb + C) * 2u; voffA[i] = (unsigned)(R * lda + C) * 2u;
        if (AKM) { const int pb = tid * 16 + i * 8192, krow = pb >> 8, c16s = (pb >> 4) & 15, f = (krow & 3) | (((krow >> 3) & 1) << 2), c16 = (((c16s >> 1) ^ f) << 1) | (c16s & 1);
            voffA[i] = (unsigned)(krow * lda + c16 * 8) * 2u; } }
    const size_t kstep = (size_t)(BK * 2), kstepA = AKM ? (size_t)BK * lda * 2 : kstep;
    const size_t hB = (size_t)(HEAD64 ? 32 : HALF) * ldb * 2;
    const size_t hA = AKM ? (size_t)HALF * 2 : (size_t)HALF * lda * 2;
    const int akoff = ((8 * fq + (fr >> 2)) << 8) + 8 * (fr & 3), akf = (fr >> 2) | ((fq & 1) << 2);
    const unsigned ldsw = (unsigned)wid * 1024u;
    const int aoff = lds_byte(wr * 64 + fr, fq * 8), boff = lds_byte(wc * 32 + fr, fq * 8);
#define G8_SA(b, h) (((b) * 2 + (h)) * HTB)
#define G8_SB(b, h) ((4 + (b) * 2 + (h)) * HTB)
#define G8_STAGE(bufoff, gbase, voff) do { const char* sb_ = (const char*)(gbase); asm volatile("" : "+s"(sb_));     \
        _Pragma("unroll") for (int _i = 0; _i < 2; ++_i) { unsigned vo_ = (voff)[_i]; asm volatile("" : "+v"(vo_));     \
        __builtin_amdgcn_global_load_lds((const unsigned*)(sb_ + vo_), (LAS unsigned*)(lds + (bufoff) + ldsw + _i * 8192), 16, 0, 0); } } while (0)
#define G8_TR(d_, a_, off_) asm volatile("ds_read_b64_tr_b16 %0, %1 offset:%2" : "=v"(d_) : "v"(a_), "n"(off_) : "memory")
#define G8_PINA do { if constexpr (AKM) asm volatile("s_waitcnt lgkmcnt(0)" : "+v"(At[0][0]), "+v"(At[0][1]), "+v"(At[1][0]), "+v"(At[1][1]), "+v"(At[2][0]), "+v"(At[2][1]), "+v"(At[3][0]), "+v"(At[3][1]) :: "memory"); } while (0)
#define G8_LDA(dst, b, h) do { if constexpr (!AKM) { _Pragma("unroll") for (int m = 0; m < 4; ++m) _Pragma("unroll") for (int k = 0; k < 2; ++k) dst[m][k] = *(const LAS bf16x8*)(lds + G8_SA(b, h) + aoff + m * 2048 + k * 1024); } \
    else { _Pragma("unroll") for (int m = 0; m < 4; ++m) { const unsigned ab_ = (unsigned)(size_t)lds + (unsigned)(akoff + (((4 * wr + m) ^ akf) << 5)); s16x4 l0_, h0_, l1_, h1_; \
        G8_TR(l0_, ab_, G8_SA(b, h)); G8_TR(h0_, ab_, G8_SA(b, h) + 1024); G8_TR(l1_, ab_, G8_SA(b, h) + 8192); G8_TR(h1_, ab_, G8_SA(b, h) + 8192 + 1024); \
        dst[m][0] = (bf16x8){l0_[0], l0_[1], l0_[2], l0_[3], h0_[0], h0_[1], h0_[2], h0_[3]}; dst[m][1] = (bf16x8){l1_[0], l1_[1], l1_[2], l1_[3], h1_[0], h1_[1], h1_[2], h1_[3]}; } } } while (0)
#define G8_LDB(dst, b, h) do { _Pragma("unroll") for (int n = 0; n < 2; ++n) _Pragma("unroll") for (int k = 0; k < 2; ++k) dst[n][k] = *(const LAS bf16x8*)(lds + G8_SB(b, h) + boff + n * 2048 + k * 1024); } while (0)
#define G8_MMA(ai, bj, At, Bt) do { __builtin_amdgcn_s_setprio(1); _Pragma("unroll") for (int m = 0; m < 4; ++m) _Pragma("unroll") for (int n = 0; n < 2; ++n) _Pragma("unroll") for (int k = 0; k < 2; ++k) \
        acc[ai][bj][m][n] = __builtin_amdgcn_mfma_f32_16x16x32_bf16(Bt[n][k], At[m][k], acc[ai][bj][m][n], 0, 0, 0); __builtin_amdgcn_s_setprio(0); } while (0)
#define G8_WAIT_V(n) asm volatile("s_waitcnt vmcnt(" #n ")" ::: "memory")
#define G8_WAIT_L(n) asm volatile("s_waitcnt lgkmcnt(" #n ")" ::: "memory")
#define G8_BAR __builtin_amdgcn_s_barrier()
#define G8_SCHED __builtin_amdgcn_sched_barrier(0)
    f32x4 acc[2][2][4][2];
#pragma unroll
    for (int a = 0; a < 2; ++a)
#pragma unroll
        for (int b = 0; b < 2; ++b)
#pragma unroll
            for (int m = 0; m < 4; ++m)
#pragma unroll
                for (int n = 0; n < 2; ++n) acc[a][b][m][n] = (f32x4){0.f, 0.f, 0.f, 0.f};
    bf16x8 At[4][2], B0[2][2], B1[2][2];
    const char* cA = cur.a; const char* cB = cur.b;
    G8_STAGE(G8_SB(0, 0), cB, voffB); G8_STAGE(G8_SB(0, 1), cB + hB, voffB); G8_STAGE(G8_SA(0, 0), cA, voffA); G8_STAGE(G8_SA(0, 1), cA + hA, voffA);
    if (wr == 1) G8_BAR;
    G8_WAIT_V(2); G8_BAR;
    G8_STAGE(G8_SB(1, 0), cB + kstep, voffB); G8_STAGE(G8_SA(1, 0), cA + kstepA, voffA); G8_STAGE(G8_SB(1, 1), cB + hB + kstep, voffB);
    G8_WAIT_V(6); G8_BAR;
    for (;;) {
        const bool has_next = S.next(ui + 1, nxt);
        const char* nA = has_next ? nxt.a : cA; const char* nB = has_next ? nxt.b : cB;
        const int nt1 = cur.nt, nt = nt1 * KREP;
        for (int t = 0; t < nt; t += 2) {
            const bool last = (t == nt - 2);
            const int t1 = (KREP > 1 && t + 1 >= nt1) ? t + 1 - nt1 : t + 1, t2 = (KREP > 1 && t + 2 >= nt1) ? t + 2 - nt1 : t + 2;
            const char* a1 = cA + (size_t)t1 * kstepA;
            const char* a2 = last ? nA : cA + (size_t)t2 * kstepA; const char* b2 = last ? nB : cB + (size_t)t2 * kstep;
            const char* a3 = a2 + kstepA; const char* b3 = b2 + kstep;
            const bool relax = (t == 0) && (ui > 0) && !(Sched::HAS_KEEP && prev_keep);
            G8_LDB(B0, 0, 0); G8_LDB(B1, 0, 1); G8_SCHED; G8_LDA(At, 0, 0); G8_STAGE(G8_SA(1, 1), a1 + hA, voffA);
            if (relax) G8_WAIT_V(24); else G8_WAIT_V(8);
            G8_WAIT_L(0); G8_PINA; G8_BAR; G8_MMA(0, 0, At, B0); G8_MMA(0, 1, At, B1); G8_BAR; G8_SCHED;
            G8_LDA(At, 0, 1); G8_STAGE(G8_SB(0, 0), b2, voffB); G8_STAGE(G8_SB(0, 1), b2 + hB, voffB); G8_STAGE(G8_SA(0, 0), a2, voffA);
            if (relax) G8_WAIT_V(24); else G8_WAIT_V(8);
            G8_WAIT_L(0); G8_PINA; G8_BAR; G8_MMA(1, 0, At, B0); G8_MMA(1, 1, At, B1); G8_BAR; G8_SCHED;
            G8_LDB(B0, 1, 0); G8_LDB(B1, 1, 1); G8_SCHED; G8_LDA(At, 1, 0); G8_STAGE(G8_SA(0, 1), a2 + hA, voffA);
            G8_WAIT_V(8); G8_WAIT_L(0); G8_PINA; G8_BAR; G8_MMA(0, 0, At, B0); G8_MMA(0, 1, At, B1); G8_BAR; G8_SCHED;
            G8_LDA(At, 1, 1); G8_STAGE(G8_SB(1, 0), b3, voffB); G8_STAGE(G8_SB(1, 1), b3 + hB, voffB); G8_STAGE(G8_SA(1, 0), a3, voffA);
            G8_WAIT_V(8); G8_WAIT_L(0); G8_PINA; G8_BAR; G8_MMA(1, 0, At, B0); G8_MMA(1, 1, At, B1); G8_BAR; G8_SCHED;
        }
        if (wr == 0) G8_BAR;
        if (KREP > 1) {
#pragma unroll
            for (int a = 0; a < 2; ++a)
#pragma unroll
                for (int b = 0; b < 2; ++b)
#pragma unroll
                    for (int m = 0; m < 4; ++m)
#pragma unroll
                        for (int n = 0; n < 2; ++n) acc[a][b][m][n] *= (1.f / KREP); }
        E(acc, cur, wr, wc, fr, fq);
        if (!has_next) break;
        if constexpr (Sched::HAS_KEEP) prev_keep = cur.keep != 0;
        if (!(Sched::HAS_KEEP && prev_keep)) {
#pragma unroll
        for (int a = 0; a < 2; ++a)
#pragma unroll
            for (int b = 0; b < 2; ++b)
#pragma unroll
                for (int m = 0; m < 4; ++m)
#pragma unroll
                    for (int n = 0; n < 2; ++n) acc[a][b][m][n] = (f32x4){0.f, 0.f, 0.f, 0.f};
        }
        cur = nxt; cA = nA; cB = nB; ++ui;
        if (wr == 1) G8_BAR;
    }
    G8_WAIT_V(0);
    G8_BAR;
#undef G8_SA
#undef G8_SB
#undef G8_STAGE
#undef G8_LDA
#undef G8_TR
#undef G8_PINA
#undef G8_LDB
#undef G8_MMA
#undef G8_WAIT_V
#undef G8_WAIT_L
#undef G8_BAR
#undef G8_SCHED
}
}

#define XB_TMO      128
#define XB_XCNT(j)  (256  + 64 * (j))
#define XB_XSUB(j)  (1280 + 64 * (j))
#define XB_XGEN(j)  (2304 + 64 * (j))
#define XB_TOP      3328
#define XB_TOPGEN   3392
#define XCD_BAR_WORDS 3456
#define XB_SPIN_CAP (1u << 18)

__device__ __forceinline__ unsigned xb_ld(unsigned* p)              { return __hip_atomic_load(p, __ATOMIC_RELAXED, __HIP_MEMORY_SCOPE_AGENT); }
__device__ __forceinline__ unsigned xb_add(unsigned* p, unsigned v) { return __hip_atomic_fetch_add(p, v, __ATOMIC_RELAXED, __HIP_MEMORY_SCOPE_AGENT); }
__device__ __forceinline__ unsigned xb_xcc_id() { return (unsigned)__builtin_amdgcn_s_getreg((3 << 11) | 20) & 0xFu; }
#define XB_SPIN(cond, bar) do { unsigned _sp = 0; while (cond) { __builtin_amdgcn_s_sleep(1); \
    if ((++_sp & 255u) == 0u) { if (xb_ld(&(bar)[XB_TMO])) break; if (_sp > XB_SPIN_CAP) { atomicAdd(&(bar)[XB_TMO], 1u); break; } } } } while (0)

struct XcdBarrier { unsigned* bar; unsigned x; volatile LAS unsigned* st; };

__device__ __forceinline__ XcdBarrier xcd_barrier_post(unsigned* bar, volatile LAS unsigned* st) {
    XcdBarrier b; b.bar = bar; b.x = xb_xcc_id(); b.st = st;
    if (threadIdx.x == 0) (void)xb_add(&bar[XB_XCNT(b.x)], 1u);
    return b;
}
__device__ __forceinline__ void xcd_barrier_complete(unsigned* bar, unsigned x, unsigned& nloc, unsigned& nx) {
    const unsigned G = gridDim.x * gridDim.y * gridDim.z;
    unsigned sum, cnt, mine, sp = 0u;
    for (;;) {
        sum = 0u; cnt = 0u; mine = 0u;
#pragma unroll
        for (unsigned j = 0; j < 16; ++j) { const unsigned c = xb_ld(&bar[XB_XCNT(j)]); sum += c; cnt += (c > 0u) ? 1u : 0u; mine = (j == x) ? c : mine; }
        if (sum == G) break;
        __builtin_amdgcn_s_sleep(1);
        if ((++sp & 255u) == 0u) { if (xb_ld(&bar[XB_TMO])) break; if (sp > XB_SPIN_CAP) { atomicAdd(&bar[XB_TMO], 1u); break; } }
    }
    nloc = mine > 0u ? mine : 1u; nx = cnt > 0u ? cnt : 1u;
}
__device__ __forceinline__ void xcd_barrier(const XcdBarrier& b) {
    asm volatile("s_waitcnt vmcnt(0)" ::: "memory");
    __syncthreads();
    if (threadIdx.x == 0) {
        unsigned* bar = b.bar;
        __builtin_amdgcn_s_waitcnt(0);
        unsigned nloc = b.st[0], nx = b.st[1];
        if (nloc == 0u) { xcd_barrier_complete(bar, b.x, nloc, nx); b.st[0] = nloc; b.st[1] = nx; }
        const unsigned old = xb_add(&bar[XB_XSUB(b.x)], 1u);
        const unsigned gen = old / nloc;
        if (old + 1u == (gen + 1u) * nloc) {
            __builtin_amdgcn_fence(__ATOMIC_RELEASE, "agent");
            asm volatile("s_waitcnt vmcnt(0)" ::: "memory");
            const unsigned og = xb_add(&bar[XB_TOP], 1u);
            const unsigned tg = og / nx;
            if (og + 1u == (tg + 1u) * nx) xb_add(&bar[XB_TOPGEN], 1u);
            else XB_SPIN(xb_ld(&bar[XB_TOPGEN]) == tg, bar);
            __builtin_amdgcn_fence(__ATOMIC_ACQUIRE, "agent");
            xb_add(&bar[XB_XGEN(b.x)], 1u);
            asm volatile("s_waitcnt vmcnt(0)" ::: "memory");
        } else {
            XB_SPIN(xb_ld(&bar[XB_XGEN(b.x)]) == gen, bar);
            __builtin_amdgcn_fence(__ATOMIC_ACQUIRE, "agent");
            asm volatile("s_waitcnt vmcnt(0)" ::: "memory");
        }
    }
    __syncthreads();
}

constexpr int NWAVES = 8, NTHR = 512;
constexpr int RING_BYTES = 131072, XTRA_OFF = RING_BYTES, LDSCTL_OFF = 163840 - 256, LDS_BYTES = 163840;
constexpr int CW_BAR = 4096, CW_PANEL = 12288;
constexpr int NPH = 8;
constexpr int NAT_REP = 1;
constexpr int FFT_REP = 1;
constexpr int KREP_[NPH] = {1, 1, 1, 1, 1, 1, 1, 1};

struct Params { const float *xp, *xs, *g_mix, *w_in, *q_norm, *k_norm, *rpb, *w_fo, *w_ao, *w_out, *g_mlp, *w1, *w2; float* out; unsigned char* ws; int ph_lo, ph_hi, li, pad; };

__device__ __forceinline__ float xsum16(float v) { const auto r = __builtin_amdgcn_permlane16_swap(__float_as_uint(v), __float_as_uint(v), false, false); return __uint_as_float(r[0]) + __uint_as_float(r[1]); }
__device__ __forceinline__ float xsum32(float v) { const auto r = __builtin_amdgcn_permlane32_swap(__float_as_uint(v), __float_as_uint(v), false, false); return __uint_as_float(r[0]) + __uint_as_float(r[1]); }
__device__ __forceinline__ float xmax16(float v) { const auto r = __builtin_amdgcn_permlane16_swap(__float_as_uint(v), __float_as_uint(v), false, false); return fmaxf(__uint_as_float(r[0]), __uint_as_float(r[1])); }
__device__ __forceinline__ float xmax32(float v) { const auto r = __builtin_amdgcn_permlane32_swap(__float_as_uint(v), __float_as_uint(v), false, false); return fmaxf(__uint_as_float(r[0]), __uint_as_float(r[1])); }
__device__ __forceinline__ float wave_sum(float v) {
#pragma unroll
    for (int o = 1; o < 64; o <<= 1) v += __shfl_xor(v, o);
    return v;
}
#define LDS_WAIT() asm volatile("s_waitcnt lgkmcnt(0)" ::: "memory")

struct WItem { const float* src; const float* gain; bf16_t* dst; int N, ldo; float sc; };
__device__ __forceinline__ bool p0_resolve(const Params& p, int it, WItem& w) {
    unsigned char* ws = p.ws;
    constexpr int I_IN = (D / 64) * (INW / 32), I_FO = (FW / 64) * (D / 32), I_AO = I_FO, I_OUT = (D / 64) * (D / 32), I_1 = (D / 64) * (DFF / 32), I_2 = (DFF / 64) * (D / 32);
    int r = it; const float* W; const float* g; bf16_t* WT; int N, ldo, co;
    if (r < I_IN) { W = p.w_in; g = p.g_mix; WT = (bf16_t*)(ws + WS_WIN); N = INW; ldo = D; co = 0; }
    else if ((r -= I_IN) < I_FO) { W = p.w_fo; g = nullptr; WT = (bf16_t*)(ws + WS_WFO); N = D; ldo = FW; co = 0; }
    else if ((r -= I_FO) < I_AO) { W = p.w_ao; g = nullptr; WT = (bf16_t*)(ws + WS_WAO); N = D; ldo = AW; co = 0; }
    else if ((r -= I_AO) < I_OUT) { W = p.w_out; g = nullptr; WT = (bf16_t*)(ws + WS_WOUT); N = D; ldo = D; co = 0; }
    else if ((r -= I_OUT) < I_1) { W = p.w1; g = p.g_mlp; WT = (bf16_t*)(ws + WS_W1); N = DFF; ldo = D; co = 0; }
    else if ((r -= I_1) < I_2) { W = p.w2; g = nullptr; WT = (bf16_t*)(ws + WS_W2); N = D; ldo = DFF; co = 0; }
    else return false;
    const int nblk = N / 32, kb = r / nblk, nb = r % nblk, k0 = 64 * kb, n0 = 32 * nb;
    w.src = W + (size_t)k0 * N + n0; w.gain = g ? g + k0 : nullptr; w.dst = WT + (size_t)n0 * ldo + co + k0; w.N = N; w.ldo = ldo; w.sc = (W == p.w_in && n0 >= 4096) ? -LOG2E : 1.f;
    return true;
}
__device__ __forceinline__ void p0_load(const WItem& w, f32x4 (&v)[8], float (&g)[8], int lane) {
#pragma unroll
    for (int j = 0; j < 8; ++j) { const int kk = (lane >> 3) + 8 * j; v[j] = *(const f32x4*)(w.src + (size_t)kk * w.N + (lane & 7) * 4); g[j] = (w.gain ? w.gain[kk] : 1.f) * w.sc; }
}
__device__ __forceinline__ void p0_process(const WItem& w, const f32x4 (&v)[8], const float (&g)[8], LAS float* scr, int lane) {
#pragma unroll
    for (int j = 0; j < 8; ++j) { const int kk = (lane >> 3) + 8 * j; LAS float* d = scr + kk * 33 + (lane & 7) * 4; const f32x4 x = v[j] * g[j]; d[0] = x[0]; d[1] = x[1]; d[2] = x[2]; d[3] = x[3]; }
    LDS_WAIT(); asm volatile("" ::: "memory");
    const int c = lane & 7;
#pragma unroll
    for (int j = 0; j < 4; ++j) { const int n = (lane >> 3) + 8 * j; const LAS float* s = scr + (8 * c) * 33 + n;
        u32x4 o; o.x = g8::cvt_pk_bf16(s[0 * 33], s[1 * 33]); o.y = g8::cvt_pk_bf16(s[2 * 33], s[3 * 33]); o.z = g8::cvt_pk_bf16(s[4 * 33], s[5 * 33]); o.w = g8::cvt_pk_bf16(s[6 * 33], s[7 * 33]);
        *(u32x4*)(w.dst + (size_t)n * w.ldo + 8 * c) = o; }
    LDS_WAIT(); asm volatile("" ::: "memory");
}
__device__ __forceinline__ void p0_xrow(const f32x4 (&v)[8], float* rstd1, bf16_t* XB, int m, int lane) {
    float s = 0.f;
#pragma unroll
    for (int j = 0; j < 8; ++j) s += (v[j].x * v[j].x + v[j].y * v[j].y) + (v[j].z * v[j].z + v[j].w * v[j].w);
    s = wave_sum(s);
    const float rs = rsqrtf(s * (1.f / D) + EPS);
    u32x2* o8 = (u32x2*)(XB + (size_t)m * D) + lane;
#pragma unroll
    for (int j = 0; j < 8; ++j) { u32x2 w; w.x = g8::cvt_pk_bf16(v[j].x * rs, v[j].y * rs); w.y = g8::cvt_pk_bf16(v[j].z * rs, v[j].w * rs); o8[64 * j] = w; }
}
__device__ __forceinline__ void p0_prologue(const Params& p, LAS unsigned char* lds, int gw, int NGW, int lane, int wave) {
    unsigned char* ws = p.ws;
    LAS float* scr = (LAS float*)(lds + wave * 16384);
    {
        WItem wa; f32x4 va[8]; float ga[8];
        for (int it = gw; p0_resolve(p, it, wa); it += NGW) { p0_load(wa, va, ga, lane); p0_process(wa, va, ga, scr, lane); }
    }
    XIn x{p.xp, p.xs}; float* rstd1 = (float*)(ws + T_RSTD1); bf16_t* XB = (bf16_t*)(ws + WS_XB);
    {
        f32x4 va[8];
        for (int m = gw; m < M; m += NGW) {
#pragma unroll
            for (int j = 0; j < 8; ++j) va[j] = ((const f32x4*)x.row(m) + lane)[64 * j];
            p0_xrow(va, rstd1, XB, m, lane); }
    }
    bf16_t* Tc = (bf16_t*)(ws + T_DFTC); bf16_t* Ts = (bf16_t*)(ws + T_DFTS);
    for (int i = gw * 64 + lane; i < 65536; i += NGW * 64) { const int a = ((i >> 8) * (i & 255)) & 255; const float ang = (float)a * (1.f / 128.f);
        Tc[i] = f2bf(cospif(ang) * S_ORTHO); Ts[i] = f2bf(sinpif(ang) * S_ORTHO); }
    { bf16_t* Tcs = (bf16_t*)(ws + T_CS);
      for (int i = gw * 64 + lane; i < 2 * 256 * 512; i += NGW * 64) { const int k = i & 511, n = (i >> 9) & 255, hh = i >> 17, cp = 128 * hh + (n & 127), a = (cp * (k & 255)) & 255; const float ang = (float)a * (1.f / 128.f);
          Tcs[i] = f2bf(k < 256 ? cospif(ang) * S_ORTHO : (n < 128 ? sinpif(ang) : -sinpif(ang)) * S_ORTHO); } }
    bf16_t* F128C = (bf16_t*)(ws + T_F128C); bf16_t* F128S = (bf16_t*)(ws + T_F128S); bf16_t* F64T = (bf16_t*)(ws + T_F64);
    for (int i = gw * 64 + lane; i < 16384; i += NGW * 64) { const int a = ((i >> 7) * (i & 127)) & 127; const float ang = (float)a * (1.f / 64.f);
        F128C[i] = f2bf(cospif(ang)); F128S[i] = f2bf(-sinpif(ang)); }
    for (int i = gw * 64 + lane; i < 3 * 64 * 72; i += NGW * 64) { const int tb = i / (64 * 72), k2 = (i / 72) % 64, sl = i % 72; float v = 0.f;
        if (sl < 64) { const int q4 = sl >> 4, hh = (sl >> 3) & 1, e = sl & 7, n2 = 16 * q4 + 8 * (e >> 2) + 4 * hh + (e & 3); const float ang = (float)((k2 * n2) & 63) * (1.f / 32.f);
            v = tb == 0 ? cospif(ang) : (tb == 1 ? sinpif(ang) : -sinpif(ang)); }
        F64T[i] = f2bf(v); }
    float* rp = (float*)(ws + T_RPB);
    for (int i = gw * 64 + lane; i < NH * 15 * 31; i += NGW * 64) rp[i] = p.rpb[i] * LOG2E;
}

template <int nM, int nN, int nt, int lda, int ldb> struct SchedGrid {
    static constexpr bool HAS_KEEP = false;
    const char* A; const char* B; int G, c;
    __device__ __forceinline__ bool next(int i, g8::Unit& u) const {
        const int L = i * G + c; if (L >= nM * nN) return false;
        int pm, pn; g8::tile_of<(nN <= 8 ? 8 : 4)>(L, nM, nN, pm, pn);
        u.pm = pm; u.pn = pn; u.nt = nt; u.keep = 0; u.br = 0;
        u.a = A + (size_t)pm * 256 * lda * 2; u.b = B + (size_t)pn * 256 * ldb * 2; return true;
    }
};
struct EpiChDft {
    bf16_t* Y;
    __device__ __forceinline__ void operator()(f32x4 (&acc)[2][2][4][2], const g8::Unit& u, int wr, int wc, int fr, int fq) const {
        if (u.keep) return;
        asm volatile("" : "+v"(fr), "+v"(fq));
        const int k0 = (u.pm & 15) * 256 + wr * 64 + fr;
        bf16_t* const Yb = Y + (size_t)(u.pm >> 4) * SEQ * FW + (u.pn * 128 + 32 * wc + 8 * fq);
#pragma unroll
        for (int ai = 0; ai < 2; ++ai)
#pragma unroll
            for (int m = 0; m < 4; ++m) { const int k = k0 + ai * 128 + m * 16;
#pragma unroll
                for (int bj = 0; bj < 2; ++bj) { const f32x4 v0 = acc[ai][bj][m][0], v1 = acc[ai][bj][m][1];
                    u32x4 w; w.x = g8::cvt_pk_bf16(v0[0], v0[1]); w.y = g8::cvt_pk_bf16(v0[2], v0[3]); w.z = g8::cvt_pk_bf16(v1[0], v1[1]); w.w = g8::cvt_pk_bf16(v1[2], v1[3]);
                    *(u32x4*)(Yb + (size_t)(bj ? ((SEQ - k) & (SEQ - 1)) : k) * FW) = w; } }
    }
};
struct EpiP1 {
    unsigned char* ws; bf16_t* gates; LAS unsigned char* xtra;
    __device__ __forceinline__ void operator()(f32x4 (&acc)[2][2][4][2], const g8::Unit& u, int wr, int wc, int fr, int fq) const {
        asm volatile("" : "+v"(fr), "+v"(fq));
        bf16_t* const Q = (bf16_t*)(ws + WS_Q); bf16_t* const Kb = (bf16_t*)(ws + WS_K); bf16_t* const V = (bf16_t*)(ws + WS_V); bf16_t* const FT = (bf16_t*)(ws + WS_FT); bf16_t* const SA = gates; bf16_t* const SB = gates + (size_t)M * D;
        const int pn = u.pn, row0 = u.pm * 256 + wr * 64 + fr;
        float rs[2][4];
#pragma unroll
        for (int ai = 0; ai < 2; ++ai)
#pragma unroll
            for (int m = 0; m < 4; ++m) rs[ai][m] = 1.f;
        if (pn < 8) {
            const bool isq = pn < 4; const LAS float* gn = (const LAS float*)(xtra + 16384) + (isq ? 0 : 64); bf16_t* O = isq ? Q : Kb; const int head = (pn & 3) * 4 + wc;
            f32x4 gv[2][2];
#pragma unroll
            for (int bj = 0; bj < 2; ++bj)
#pragma unroll
                for (int n = 0; n < 2; ++n) gv[bj][n] = *(const LAS f32x4*)(gn + 32 * bj + 8 * fq + 4 * n);
#pragma unroll
            for (int ai = 0; ai < 2; ++ai)
#pragma unroll
                for (int m = 0; m < 4; ++m) { const int r = row0 + ai * 128 + m * 16; const float rsv = rs[ai][m]; float ss = 0.f;
#pragma unroll
                    for (int bj = 0; bj < 2; ++bj)
#pragma unroll
                        for (int n = 0; n < 2; ++n) { const f32x4 v = acc[ai][bj][m][n]; ss += (v[0] * v[0] + v[1] * v[1]) + (v[2] * v[2] + v[3] * v[3]); }
                    ss = xsum32(xsum16(ss));
                    const float rn = rsqrtf(ss * rsv * rsv * (1.f / 64.f) + EPS) * rsv * (isq ? QSCALE : 1.f);
#pragma unroll
                    for (int bj = 0; bj < 2; ++bj) { const f32x4 v0 = acc[ai][bj][m][0] * rn * gv[bj][0], v1 = acc[ai][bj][m][1] * rn * gv[bj][1];
                        u32x4 w; w.x = g8::cvt_pk_bf16(v0[0], v0[1]); w.y = g8::cvt_pk_bf16(v0[2], v0[3]); w.z = g8::cvt_pk_bf16(v1[0], v1[1]); w.w = g8::cvt_pk_bf16(v1[2], v1[3]);
                        *(u32x4*)(O + (size_t)r * AW + head * 64 + 32 * bj + 8 * fq) = w; } }
        } else if (pn >= 12 && pn < 16) {
            const int b = (u.pm * 256) / SEQ; bf16_t* Fb = FT + ((size_t)b * FW + (pn - 12) * 256 + wr * 64 + fr) * SEQ + (u.pm * 256 - b * SEQ);
#pragma unroll
            for (int ai = 0; ai < 2; ++ai)
#pragma unroll
                for (int m = 0; m < 4; ++m) { bf16_t* rowp = Fb + (size_t)(ai * 128 + m * 16) * SEQ;
#pragma unroll
                    for (int bj = 0; bj < 2; ++bj) { const f32x4 v0 = acc[ai][bj][m][0], v1 = acc[ai][bj][m][1];
                        u32x4 w; w.x = g8::cvt_pk_bf16(v0[0], v0[1]); w.y = g8::cvt_pk_bf16(v0[2], v0[3]); w.z = g8::cvt_pk_bf16(v1[0], v1[1]); w.w = g8::cvt_pk_bf16(v1[2], v1[3]);
                        *(u32x4*)(rowp + g8::colbase<true>(bj, wc, fq)) = w; } }
        } else if (pn < 12) { store_rows<false>(acc, rs, V, AW, (pn - 8) * 256, row0, wc, fq);
        } else { store_rows<true>(acc, rs, pn < 24 ? SA : SB, D, ((pn - 16) & 7) * 256, row0, wc, fq); }
    }
    template <bool SIG> __device__ __forceinline__ void store_rows(const f32x4 (&acc)[2][2][4][2], const float (&rs)[2][4], bf16_t* O, int ldo, int cb, int row0, int wc, int fq) const {
#pragma unroll
        for (int ai = 0; ai < 2; ++ai)
#pragma unroll
            for (int m = 0; m < 4; ++m) { const int r = row0 + ai * 128 + m * 16; const float rsv = rs[ai][m];
#pragma unroll
                for (int bj = 0; bj < 2; ++bj) { f32x4 v0 = acc[ai][bj][m][0] * rsv, v1 = acc[ai][bj][m][1] * rsv;
                    if (SIG) {
#pragma unroll
                        for (int e = 0; e < 4; ++e) { v0[e] = __builtin_amdgcn_rcpf(1.f + __builtin_amdgcn_exp2f(v0[e])); v1[e] = __builtin_amdgcn_rcpf(1.f + __builtin_amdgcn_exp2f(v1[e])); } }
                    u32x4 w; w.x = g8::cvt_pk_bf16(v0[0], v0[1]); w.y = g8::cvt_pk_bf16(v0[2], v0[3]); w.z = g8::cvt_pk_bf16(v1[0], v1[1]); w.w = g8::cvt_pk_bf16(v1[2], v1[3]);
                    *(u32x4*)(O + (size_t)r * ldo + cb + g8::colbase<true>(bj, wc, fq)) = w; }
                __builtin_amdgcn_sched_barrier(0); }
    }
};

struct SchedP1 {
    static constexpr bool HAS_KEEP = false;
    const char* XB; const char* W; int G, c;
    __device__ __forceinline__ bool next(int i, g8::Unit& u) const {
        const int L = i * G + c; if (L >= (M / 256) * (INW / 256)) return false;
        int pm, pn; g8::tile_of<4>(L, M / 256, INW / 256, pm, pn);
        u.pm = pm; u.pn = pn; u.nt = D / 64; u.keep = 0; u.br = 0;
        const char* xa = XB + (size_t)pm * 256 * D * 2; const char* wb = W + (size_t)pn * 256 * D * 2; const bool sw = pn >= 12 && pn < 16;
        u.a = sw ? wb : xa; u.b = sw ? xa : wb; return true;
    }
};
struct SchedChDft {
    static constexpr bool HAS_KEEP = true;
    const char* PT; const char* TCS; int G, c;
    __device__ __forceinline__ bool next(int i, g8::Unit& u) const {
        const int L = (i >> 1) * G + c; if (L >= 48 * 8) return false;
        int pm, pn; g8::tile_of<8>(L, 48, 8, pm, pn); const int seg = i & 1, g = pn >> 1, h = pn & 1;
        u.pm = pm; u.pn = pn; u.nt = 4; u.keep = seg == 0; u.br = 0;
        u.a = PT + ((size_t)((pm >> 4) * 2 + seg) * FW + g * 256) * SEQ * 2 + (size_t)(pm & 15) * 256 * 2; u.b = TCS + (size_t)h * 256 * 512 * 2 + seg * 256 * 2; return true;
    }
};
struct SchedMerge2 {
    static constexpr bool HAS_KEEP = false;
    const char* Y; const char* ATT; const char* WFO; const char* WAO; int G, c;
    __device__ __forceinline__ bool next(int i, g8::Unit& u) const {
        const int L = (i >> 1) * G + c; if (L >= 96 * 8) return false;
        int pm, pn; g8::tile_of<8>(L, 96, 8, pm, pn); const int br = i & 1;
        u.pm = pm; u.pn = pn; u.nt = 16; u.keep = 0; u.br = br;
        u.a = (br ? ATT : Y) + (size_t)pm * 256 * 1024 * 2; u.b = (br ? WAO : WFO) + (size_t)pn * 256 * 1024 * 2; return true;
    }
};
__device__ __forceinline__ f32x4 bf_lo4(const u32x4 w, int half) { return half == 0 ? (f32x4){__uint_as_float(w[0] << 16), __uint_as_float(w[0] & 0xffff0000u), __uint_as_float(w[1] << 16), __uint_as_float(w[1] & 0xffff0000u)}
                                                                                       : (f32x4){__uint_as_float(w[2] << 16), __uint_as_float(w[2] & 0xffff0000u), __uint_as_float(w[3] << 16), __uint_as_float(w[3] & 0xffff0000u)}; }
__device__ __forceinline__ u32x4 pack8(const f32x4 v0, const f32x4 v1) { u32x4 w; w.x = g8::cvt_pk_bf16(v0[0], v0[1]); w.y = g8::cvt_pk_bf16(v0[2], v0[3]); w.z = g8::cvt_pk_bf16(v1[0], v1[1]); w.w = g8::cvt_pk_bf16(v1[2], v1[3]); return w; }
struct EpiMerge {
    unsigned char* ws; const bf16_t* gates;
    template <bool SECOND> __device__ __forceinline__ void run(f32x4 (&acc)[2][2][4][2], const g8::Unit& u, int wr, int wc, int fr, int fq) const {
        asm volatile("" : "+v"(fr), "+v"(fq));
        bf16_t* const MG = (bf16_t*)(ws + WS_MERGED); const bf16_t* const SA = gates; const bf16_t* const SB = gates + (size_t)M * D;
        const char* S = (const char*)(SECOND ? SB : SA); char* const MGb = (char*)MG;
        unsigned o0 = ((unsigned)(u.pm * 256 + wr * 64 + fr) * D + u.pn * 256 + g8::colbase<false>(0, wc, fq)) * 2u;
#define MRG_LD(d_, off_, base_) asm volatile("global_load_dwordx4 %0, %1, %2" : "=v"(d_) : "v"(off_), "s"(base_) : "memory")
#define MRG_OFF(ai_, m_, bj_) (o0 + (unsigned)((((ai_) * 128 + (m_) * 16) * D + (bj_) * 128) * 2))
        u32x4 ow[2][4][2];
        if constexpr (!SECOND) {
            u32x4 sg[2][4][2];
#pragma unroll
            for (int ai = 0; ai < 2; ++ai)
#pragma unroll
                for (int m = 0; m < 4; ++m)
#pragma unroll
                    for (int bj = 0; bj < 2; ++bj) { const unsigned o = MRG_OFF(ai, m, bj); MRG_LD(sg[ai][m][bj], o, S); }
#define MRG_ST0(ai_, m_, W_) do { asm volatile(W_ : "+v"(sg[ai_][m_][0]), "+v"(sg[ai_][m_][1]) :: "memory"); \
                _Pragma("unroll") for (int bj = 0; bj < 2; ++bj) ow[ai_][m_][bj] = pack8(bf_lo4(sg[ai_][m_][bj], 0) * acc[ai_][bj][m_][0], bf_lo4(sg[ai_][m_][bj], 1) * acc[ai_][bj][m_][1]); __builtin_amdgcn_sched_barrier(0); } while (0)
            MRG_ST0(0, 0, "s_waitcnt vmcnt(14)"); MRG_ST0(0, 1, "s_waitcnt vmcnt(12)"); MRG_ST0(0, 2, "s_waitcnt vmcnt(10)"); MRG_ST0(0, 3, "s_waitcnt vmcnt(8)");
            MRG_ST0(1, 0, "s_waitcnt vmcnt(6)"); MRG_ST0(1, 1, "s_waitcnt vmcnt(4)"); MRG_ST0(1, 2, "s_waitcnt vmcnt(2)"); MRG_ST0(1, 3, "s_waitcnt vmcnt(0)");
#undef MRG_ST0
        } else {
#pragma unroll
            for (int ai = 0; ai < 2; ++ai) {
                u32x4 sg[4][2], pv[4][2];
#pragma unroll
                for (int m = 0; m < 4; ++m)
#pragma unroll
                    for (int bj = 0; bj < 2; ++bj) { const unsigned o = MRG_OFF(ai, m, bj); MRG_LD(sg[m][bj], o, S); MRG_LD(pv[m][bj], o, MGb); }
#define MRG_ST1(m_, W_) do { asm volatile(W_ : "+v"(sg[m_][0]), "+v"(sg[m_][1]), "+v"(pv[m_][0]), "+v"(pv[m_][1]) :: "memory"); \
                _Pragma("unroll") for (int bj = 0; bj < 2; ++bj) ow[ai][m_][bj] = pack8(bf_lo4(sg[m_][bj], 0) * acc[ai][bj][m_][0] + bf_lo4(pv[m_][bj], 0), bf_lo4(sg[m_][bj], 1) * acc[ai][bj][m_][1] + bf_lo4(pv[m_][bj], 1)); __builtin_amdgcn_sched_barrier(0); } while (0)
                MRG_ST1(0, "s_waitcnt vmcnt(12)"); MRG_ST1(1, "s_waitcnt vmcnt(8)"); MRG_ST1(2, "s_waitcnt vmcnt(4)"); MRG_ST1(3, "s_waitcnt vmcnt(0)");
#undef MRG_ST1
            }
        }
#undef MRG_LD
#undef MRG_OFF
#pragma unroll
        for (int ai = 0; ai < 2; ++ai)
#pragma unroll
            for (int m = 0; m < 4; ++m)
#pragma unroll
                for (int bj = 0; bj < 2; ++bj) *(u32x4*)(MGb + (o0 + (unsigned)(((ai * 128 + m * 16) * D + bj * 128) * 2))) = ow[ai][m][bj];
    }
};
struct EpiMergeBr { EpiMerge e;
    __device__ __forceinline__ void operator()(f32x4 (&acc)[2][2][4][2], const g8::Unit& u, int wr, int wc, int fr, int fq) const { if (u.br) e.template run<true>(acc, u, wr, wc, fr, fq); else e.template run<false>(acc, u, wr, wc, fr, fq); } };
struct EpiX1 {
    XIn x; unsigned char* ws;
    __device__ __forceinline__ void operator()(f32x4 (&acc)[2][2][4][2], const g8::Unit& u, int wr, int wc, int fr, int fq) const {
        asm volatile("" : "+v"(fr), "+v"(fq));
        bf16_t* const X1B = (bf16_t*)(ws + WS_X1B); float* const SSQ = (float*)(ws + WS_SSQ);
        const int row0 = u.pm * 256 + wr * 64 + fr; const char* xbase = (const char*)((u.pm < SEQ / 256) ? x.xp : x.xs - (size_t)SEQ * D);
        const unsigned e0 = (unsigned)row0 * D + u.pn * 256 + g8::colbase<false>(0, wc, fq);
        u32x4 ow[2][4][2]; float ssr[2][4]; unsigned tok = 0;
#pragma unroll
        for (int ai = 0; ai < 2; ++ai) {
#pragma unroll
            for (int m = 0; m < 4; ++m) { const unsigned er = e0 + tok + (unsigned)((ai * 128 + m * 16) * D); float ss = 0.f;
#pragma unroll
                for (int bj = 0; bj < 2; ++bj) { const char* xr = xbase + (er + bj * 128) * 4u;
                    const f32x4 v0 = acc[ai][bj][m][0] + *(const f32x4*)xr, v1 = acc[ai][bj][m][1] + *(const f32x4*)(xr + 16);
                    ss += (v0[0] * v0[0] + v0[1] * v0[1]) + (v0[2] * v0[2] + v0[3] * v0[3]) + (v1[0] * v1[0] + v1[1] * v1[1]) + (v1[2] * v1[2] + v1[3] * v1[3]);
                    ow[ai][m][bj] = pack8(v0, v1); }
                if (m == 3) asm volatile("" : "+v"(tok), "+v"(ss));
                ssr[ai][m] = ss; } }
        asm volatile("" ::: "memory");
#pragma unroll
        for (int ai = 0; ai < 2; ++ai)
#pragma unroll
            for (int m = 0; m < 4; ++m) { const int r = row0 + ai * 128 + m * 16;
#pragma unroll
                for (int bj = 0; bj < 2; ++bj) *(u32x4*)((char*)X1B + (e0 + (unsigned)((ai * 128 + m * 16) * D + bj * 128)) * 2u) = ow[ai][m][bj];
                float ss = ssr[ai][m]; ss = xsum32(xsum16(ss));
                if (fq == 0) *(float*)((char*)SSQ + ((unsigned)r * 32u + u.pn * 4 + wc) * 4u) = ss; }
    }
};
__device__ __forceinline__ size_t tmp_base(int pm) { return pm < 48 ? WS_TMP0 : (WS_TMP1 - (size_t)48 * MiB); }
struct EpiTmp {
    unsigned char* ws;
    __device__ __forceinline__ void operator()(f32x4 (&acc)[2][2][4][2], const g8::Unit& u, int wr, int wc, int fr, int fq) const {
        asm volatile("" : "+v"(fr), "+v"(fq));
        const int row0 = u.pm * 256 + wr * 64 + fr; bf16_t* T = (bf16_t*)(ws + tmp_base(u.pm));
#pragma unroll
        for (int ai = 0; ai < 2; ++ai)
#pragma unroll
            for (int m = 0; m < 4; ++m) { bf16_t* rowp = T + (size_t)(row0 + ai * 128 + m * 16) * D + (u.pn * 256);
#pragma unroll
                for (int bj = 0; bj < 2; ++bj) { const f32x4 v0 = acc[ai][bj][m][0], v1 = acc[ai][bj][m][1];
                    u32x4 w; w.x = g8::cvt_pk_bf16(v0[0], v0[1]); w.y = g8::cvt_pk_bf16(v0[2], v0[3]); w.z = g8::cvt_pk_bf16(v1[0], v1[1]); w.w = g8::cvt_pk_bf16(v1[2], v1[3]);
                    *(u32x4*)(rowp + g8::colbase<false>(bj, wc, fq)) = w; } }
    }
};
struct EpiOut {
    float* out; const unsigned char* ws;
    __device__ __forceinline__ void operator()(f32x4 (&acc)[2][2][4][2], const g8::Unit& u, int wr, int wc, int fr, int fq) const {
        asm volatile("" : "+v"(fr), "+v"(fq));
        const bf16_t* const X1B = (const bf16_t*)(ws + WS_X1B); const float* const r2 = (const float*)(ws + T_RSTD2);
        const int row0 = u.pm * 256 + wr * 64 + fr; const bf16_t* T = (const bf16_t*)(ws + tmp_base(u.pm));
#pragma unroll
        for (int ai = 0; ai < 2; ++ai) {
#pragma unroll
            for (int m = 0; m < 4; ++m) { const int r = row0 + ai * 128 + m * 16; const float sc = r2[r]; const size_t ro = (size_t)r * D + (u.pn * 256);
#pragma unroll
                for (int bj = 0; bj < 2; ++bj) { const size_t o = ro + g8::colbase<false>(bj, wc, fq);
                    const u32x4 tv = *(const u32x4*)(T + o), xv = *(const u32x4*)(X1B + o);
                    const f32x4 r0 = bf_lo4(xv, 0) + (bf_lo4(tv, 0) + acc[ai][bj][m][0]) * sc, r1 = bf_lo4(xv, 1) + (bf_lo4(tv, 1) + acc[ai][bj][m][1]) * sc;
                    acc[ai][bj][m][0] = r0; acc[ai][bj][m][1] = r1; } }
            asm volatile("" ::: "memory"); }
#pragma unroll
        for (int ai = 0; ai < 2; ++ai)
#pragma unroll
            for (int m = 0; m < 4; ++m) { float* rowp = out + (size_t)(row0 + ai * 128 + m * 16) * D + (u.pn * 256);
#pragma unroll
                for (int bj = 0; bj < 2; ++bj) { const int cb = g8::colbase<false>(bj, wc, fq);
                    *(f32x4*)(rowp + cb) = acc[ai][bj][m][0]; *(f32x4*)(rowp + cb + 4) = acc[ai][bj][m][1]; } }
    }
};
__device__ __forceinline__ float relu_i(float x) { const int i = __builtin_bit_cast(int, x); return __builtin_bit_cast(float, i > 0 ? i : 0); }
struct EpiRelu2 {
    bf16_t* Ua; bf16_t* Ub;
    __device__ __forceinline__ void operator()(f32x4 (&acc)[2][2][4][2], const g8::Unit& u, int wr, int wc, int fr, int fq) const {
        asm volatile("" : "+v"(fr), "+v"(fq));
        const int row0 = u.pm * 256 + wr * 64 + fr; bf16_t* const U = (u.pn < 16) ? Ua : Ub; const int cb0 = (u.pn & 15) * 256;
#pragma unroll
        for (int ai = 0; ai < 2; ++ai)
#pragma unroll
            for (int m = 0; m < 4; ++m) { bf16_t* rowp = U + (size_t)(row0 + ai * 128 + m * 16) * 4096 + cb0;
#pragma unroll
                for (int bj = 0; bj < 2; ++bj) { f32x4 v0 = acc[ai][bj][m][0], v1 = acc[ai][bj][m][1];
#pragma unroll
                    for (int e = 0; e < 4; ++e) { const float a = relu_i(v0[e]), b = relu_i(v1[e]); v0[e] = a * a; v1[e] = b * b; }
                    u32x4 w; w.x = g8::cvt_pk_bf16(v0[0], v0[1]); w.y = g8::cvt_pk_bf16(v0[2], v0[3]); w.z = g8::cvt_pk_bf16(v1[0], v1[1]); w.w = g8::cvt_pk_bf16(v1[2], v1[3]);
                    *(u32x4*)(rowp + g8::colbase<false>(bj, wc, fq)) = w; } }
    }
};
struct SchedDown {
    static constexpr bool HAS_KEEP = true;
    const char* Ua; const char* Ub; const char* W2; int G, c;
    __device__ __forceinline__ bool next(int i, g8::Unit& u) const {
        const int L = (i >> 1) * G + c; if (L >= 96 * 8) return false;
        int pm, pn; g8::tile_of<4>(L, 96, 8, pm, pn); const int seg = i & 1;
        u.pm = pm; u.pn = pn; u.nt = 64; u.keep = seg == 0; u.br = 0;
        u.a = (seg ? Ua : Ub) + (size_t)pm * 256 * 4096 * 2; u.b = W2 + ((size_t)pn * 256 * DFF + (seg ? 0 : 4096)) * 2; return true;
    }
};
struct EpiDown {
    float* out; const unsigned char* ws; unsigned* pcnt;
    __device__ __forceinline__ void operator()(f32x4 (&acc)[2][2][4][2], const g8::Unit& u, int wr, int wc, int fr, int fq) const {
        const bool t0 = (wr == 0) && (wc == 0) && (fr == 0) && (fq == 0);
        unsigned* cnt = pcnt + 16 * u.pm;
        if (u.keep) {
            if (t0) __hip_atomic_fetch_add(cnt, 1u, __ATOMIC_RELAXED, __HIP_MEMORY_SCOPE_AGENT);
            return; }
        if (t0) { unsigned sp = 0; while (__hip_atomic_load(cnt, __ATOMIC_RELAXED, __HIP_MEMORY_SCOPE_AGENT) < 8u && ++sp < (1u << 16)) __builtin_amdgcn_s_sleep(2); }
        __builtin_amdgcn_s_barrier();
        asm volatile("" : "+v"(fr), "+v"(fq));
        const bf16_t* const X1B = (const bf16_t*)(ws + WS_X1B); const float* const r2 = (const float*)(ws + T_RSTD2);
        const int row0 = u.pm * 256 + wr * 64 + fr;
        const unsigned e0 = (unsigned)row0 * D + u.pn * 256 + g8::colbase<false>(0, wc, fq);
#pragma unroll
        for (int ai = 0; ai < 2; ++ai) {
            u32x4 xv[4][2]; float scv[4];
#pragma unroll
            for (int m = 0; m < 4; ++m) { const float sc = *(const float*)((const char*)r2 + (unsigned)(row0 + ai * 128 + m * 16) * 4u);
#pragma unroll
                for (int bj = 0; bj < 2; ++bj) xv[m][bj] = *(const u32x4*)((const char*)X1B + (e0 + (unsigned)((ai * 128 + m * 16) * D + bj * 128)) * 2u);
                scv[m] = sc; }
            asm volatile("" : "+v"(xv[0][0]), "+v"(xv[0][1]), "+v"(xv[1][0]), "+v"(xv[1][1]), "+v"(xv[2][0]), "+v"(xv[2][1]), "+v"(xv[3][0]), "+v"(xv[3][1]));
#pragma unroll
            for (int m = 0; m < 4; ++m) {
#pragma unroll
                for (int bj = 0; bj < 2; ++bj) { char* op = (char*)out + (e0 + (unsigned)((ai * 128 + m * 16) * D + bj * 128)) * 4u;
                    const f32x4 r0 = bf_lo4(xv[m][bj], 0) + acc[ai][bj][m][0] * scv[m], r1 = bf_lo4(xv[m][bj], 1) + acc[ai][bj][m][1] * scv[m];
                    *(f32x4*)op = r0; *(f32x4*)(op + 16) = r1; }
                __builtin_amdgcn_sched_barrier(0); }
            asm volatile("" ::: "memory"); }
    }
};
typedef short v4i16_t __attribute__((ext_vector_type(4)));
__device__ __forceinline__ void natten_phase(const Params& p, LAS unsigned char* lds, int G, int bx, int tid, int lane, int wave) {
    unsigned char* ws = p.ws;
    const bf16_t* Qg = (const bf16_t*)(ws + WS_Q); const bf16_t* Kg = (const bf16_t*)(ws + WS_K); const bf16_t* Vg = (const bf16_t*)(ws + WS_V); bf16_t* ATT = (bf16_t*)(ws + WS_ATT);
    const float* rp = (const float*)(ws + T_RPB);
    LAS float* biasT = (LAS float*)(lds + XTRA_OFF);
    const int j = lane & 15, q = lane >> 4, qq = j >> 2, pp = j & 3;
    constexpr int QOFF = XTRA_OFF + 4096;
    const int wv = __builtin_amdgcn_readfirstlane(wave);
    const int keyl = (wv & 3) * 8 + (lane >> 3), pch = lane & 7;
    const unsigned voK = (unsigned)(keyl * AW + ((pch ^ ((keyl >> 1) & 7)) << 3)) * 2u, voV = (unsigned)(keyl * AW + ((pch ^ (2 * ((keyl >> 1) & 3))) << 3)) * 2u;
    const unsigned voQ = (unsigned)((lane >> 3) * AW + pch * 8) * 2u, voB = (unsigned)lane * 4u;
#define NAT_PIECE(sb_expr_, vo_, ldsoff_, sz_) do { const char* sb_ = (sb_expr_); asm volatile("" : "+s"(sb_)); unsigned vv_ = (vo_); asm volatile("" : "+v"(vv_)); \
        __builtin_amdgcn_global_load_lds((const unsigned*)(sb_ + vv_), (LAS unsigned*)(lds + (ldsoff_)), sz_, 0, 0); } while (0)
#define NAT_DMA_KV(it2_, gbase_, ldsoff_, vo_) do { const int g2 = (it2_) & 3, rb2 = ((it2_) >> 2) & 15, h2 = ((it2_) >> 6) & 15, b2 = (it2_) >> 10; \
        const int base2 = min(max(8 * rb2 - 4, 0), 112), kcb2 = (g2 == 0) ? 0 : (g2 == 1) ? 8 : (g2 == 2) ? 24 : 32; \
        const char* sb0_ = (const char*)(gbase_) + (size_t)((((unsigned)b2 * SEQ + (base2 + (wv >> 2)) * 64 + kcb2) * AW + h2 * HD) * 2u); \
        _Pragma("unroll") for (int jj = 0; jj < 8; ++jj) NAT_PIECE(sb0_ + jj * 262144, vo_, (ldsoff_) + 8192 * jj + 1024 * wv, 16); } while (0)
#define NAT_DMA_QB(it2_) do { const int g2 = (it2_) & 3, rb2 = ((it2_) >> 2) & 15, h2 = ((it2_) >> 6) & 15, b2 = (it2_) >> 10; \
        const char* sq_ = (const char*)Qg + (size_t)((((unsigned)b2 * SEQ + (8 * rb2 + wv) * 64 + 16 * g2) * AW + h2 * HD) * 2u); \
        NAT_PIECE(sq_, voQ, QOFF + 2048 * wv, 16); NAT_PIECE(sq_ + 8 * AW * 2, voQ, QOFF + 2048 * wv + 1024, 16); \
        NAT_PIECE((const char*)rp + (size_t)((h2 * 465 + 64 * wv) * 4), voB, XTRA_OFF + 256 + 256 * wv, 4); } while (0)
    if (bx < 3072) { NAT_DMA_QB(bx); NAT_DMA_KV(bx, Kg, 0, voK); asm volatile("s_waitcnt vmcnt(0)" ::: "memory"); NAT_DMA_KV(bx, Vg, 65536, voV); }
    for (int it = bx; it < 3072; it += G) {
        const int g = it & 3, rb = (it >> 2) & 15, h = (it >> 6) & 15, b = it >> 10;
        const int base = min(max(8 * rb - 4, 0), 112), kcb = (g == 0) ? 0 : (g == 1) ? 8 : (g == 2) ? 24 : 32;
        const int itn = (it + G < 3072) ? it + G : it;
        asm volatile("s_waitcnt vmcnt(10)" ::: "memory");
        __builtin_amdgcn_s_barrier(); asm volatile("" ::: "memory");
        const int r = 8 * rb + wave, rs = min(max(r - 4, 0), 120), s0 = rs - base, c = 16 * g + j, cs = min(max(c - 8, 0), 48);
        bool sel[4]; int bix[4];
#pragma unroll
        for (int e = 0; e < 4; ++e) { const int kc0 = kcb + 4 * q + e; sel[e] = kc0 >= cs; bix[e] = 64 + (rs - r + 7) * 31 + 15 - c + kc0 + (sel[e] ? 0 : 16); }
        const unsigned m01 = (sel[0] ? 0xFFFFu : 0u) | (sel[1] ? 0xFFFF0000u : 0u), m23 = (sel[2] ? 0xFFFFu : 0u) | (sel[3] ? 0xFFFF0000u : 0u);
#define NAT_RD128(d_, a_, off_) asm volatile("ds_read_b128 %0, %1 offset:%2" : "=v"(d_) : "v"(a_), "n"(off_) : "memory")
#define NAT_RD32(d_, a_, off_) asm volatile("ds_read_b32 %0, %1 offset:%2" : "=v"(d_) : "v"(a_), "n"(off_) : "memory")
        const unsigned lb_ = (unsigned)(size_t)lds;
        unsigned kb_[2][2], bb_[4];
#pragma unroll
        for (int hf = 0; hf < 2; ++hf) { const int key = 16 * hf + j, ka = (s0 * 32 + key) * 128, sw = (key >> 1) & 7; kb_[hf][0] = lb_ + ka + ((q ^ sw) << 4); kb_[hf][1] = lb_ + ka + (((4 + q) ^ sw) << 4); }
#pragma unroll
        for (int e = 0; e < 4; ++e) bb_[e] = lb_ + XTRA_OFF + 4 * bix[e];
        bf16x8 qf0, qf1; { const unsigned qa_ = lb_ + QOFF + 2048 * wv + j * 128 + q * 16; NAT_RD128(qf0, qa_, 0); NAT_RD128(qf1, qa_, 64); }
        f32x4 S[8][2];
        bf16x8 kf[2][2][2]; float bz[2][4];
#define NAT_READS(bf_, a_) do { \
            NAT_RD128(kf[bf_][0][0], kb_[0][0], (a_) * 4096); NAT_RD128(kf[bf_][0][1], kb_[0][1], (a_) * 4096); NAT_RD128(kf[bf_][1][0], kb_[1][0], (a_) * 4096); NAT_RD128(kf[bf_][1][1], kb_[1][1], (a_) * 4096); \
            NAT_RD32(bz[bf_][0], bb_[0], (a_) * 124); NAT_RD32(bz[bf_][1], bb_[1], (a_) * 124); NAT_RD32(bz[bf_][2], bb_[2], (a_) * 124); NAT_RD32(bz[bf_][3], bb_[3], (a_) * 124); } while (0)
#define NAT_SCORE(bf_, a_, WAITSTR_) do { \
            asm volatile(WAITSTR_ : "+v"(kf[bf_][0][0]), "+v"(kf[bf_][0][1]), "+v"(kf[bf_][1][0]), "+v"(kf[bf_][1][1]), "+v"(bz[bf_][0]), "+v"(bz[bf_][1]), "+v"(bz[bf_][2]), "+v"(bz[bf_][3]), "+v"(qf0), "+v"(qf1) :: "memory"); \
            { const f32x4 bzv = {bz[bf_][0], bz[bf_][1], bz[bf_][2], bz[bf_][3]}; \
                _Pragma("unroll") for (int hf = 0; hf < 2; ++hf) { f32x4 z = __builtin_amdgcn_mfma_f32_16x16x32_bf16(kf[bf_][hf][0], qf0, bzv, 0, 0, 0); \
                    S[a_][hf] = __builtin_amdgcn_mfma_f32_16x16x32_bf16(kf[bf_][hf][1], qf1, z, 0, 0, 0); } } } while (0)
        NAT_READS(0, 0);
        NAT_READS(1, 1); NAT_SCORE(0, 0, "s_waitcnt lgkmcnt(8)"); NAT_READS(0, 2); NAT_SCORE(1, 1, "s_waitcnt lgkmcnt(8)"); NAT_READS(1, 3); NAT_SCORE(0, 2, "s_waitcnt lgkmcnt(8)");
        NAT_READS(0, 4); NAT_SCORE(1, 3, "s_waitcnt lgkmcnt(8)"); NAT_READS(1, 5); NAT_SCORE(0, 4, "s_waitcnt lgkmcnt(8)"); NAT_READS(0, 6); NAT_SCORE(1, 5, "s_waitcnt lgkmcnt(8)");
        NAT_READS(1, 7); NAT_SCORE(0, 6, "s_waitcnt lgkmcnt(8)"); NAT_SCORE(1, 7, "s_waitcnt lgkmcnt(0)");
#undef NAT_READS
#undef NAT_SCORE
#undef NAT_RD128
#undef NAT_RD32
        asm volatile("s_waitcnt vmcnt(0)" ::: "memory");
        __builtin_amdgcn_s_barrier(); asm volatile("" ::: "memory");
        NAT_DMA_QB(itn); NAT_DMA_KV(itn, Kg, 0, voK);
        f32x4 Sf[8]; float mx = -INFINITY;
#pragma unroll
        for (int a = 0; a < 8; ++a)
#pragma unroll
            for (int e = 0; e < 4; ++e) { const float sv = sel[e] ? S[a][0][e] : S[a][1][e]; Sf[a][e] = sv; mx = fmaxf(mx, sv); }
        mx = xmax32(xmax16(mx));
        float l = 0.f;
#pragma unroll
        for (int a = 0; a < 8; ++a)
#pragma unroll
            for (int e = 0; e < 4; ++e) { const float pv = __builtin_amdgcn_exp2f(Sf[a][e] - mx); Sf[a][e] = pv; l += pv; }
        l = xsum32(xsum16(l));
        f32x4 O[4];
#pragma unroll
        for (int dt = 0; dt < 4; ++dt) O[dt] = (f32x4){0.f, 0.f, 0.f, 0.f};
        unsigned vb_[4][2];
#pragma unroll
        for (int dt = 0; dt < 4; ++dt) { const int kk0 = 4 * q + qq, kk1 = 16 + 4 * q + qq, chunk = 2 * dt + (pp >> 1);
            vb_[dt][0] = (unsigned)(size_t)lds + 65536 + (s0 * 32 + kk0) * 128 + ((chunk ^ (2 * ((kk0 >> 1) & 3))) << 4) + (pp & 1) * 8;
            vb_[dt][1] = (unsigned)(size_t)lds + 65536 + (s0 * 32 + kk1) * 128 + ((chunk ^ (2 * ((kk1 >> 1) & 3))) << 4) + (pp & 1) * 8; }
        asm volatile("" : "+v"(vb_[0][0]), "+v"(vb_[0][1]), "+v"(vb_[1][0]), "+v"(vb_[1][1]), "+v"(vb_[2][0]), "+v"(vb_[2][1]), "+v"(vb_[3][0]), "+v"(vb_[3][1]));
#define NAT_TR(d_, a_, off_) asm volatile("ds_read_b64_tr_b16 %0, %1 offset:%2" : "=v"(d_) : "v"(a_), "n"(off_) : "memory")
        v4i16_t lo[2][4], hi[2][4];
#define NAT_READV(bf_, a_) do { NAT_TR(lo[bf_][0], vb_[0][0], (a_) * 4096); NAT_TR(hi[bf_][0], vb_[0][1], (a_) * 4096); NAT_TR(lo[bf_][1], vb_[1][0], (a_) * 4096); NAT_TR(hi[bf_][1], vb_[1][1], (a_) * 4096); \
            NAT_TR(lo[bf_][2], vb_[2][0], (a_) * 4096); NAT_TR(hi[bf_][2], vb_[2][1], (a_) * 4096); NAT_TR(lo[bf_][3], vb_[3][0], (a_) * 4096); NAT_TR(hi[bf_][3], vb_[3][1], (a_) * 4096); } while (0)
#define NAT_PV_ROW(a_, bf_, WAITSTR_) do { const unsigned p01 = g8::cvt_pk_bf16(Sf[a_][0], Sf[a_][1]), p23 = g8::cvt_pk_bf16(Sf[a_][2], Sf[a_][3]); \
            u32x4 pw; pw.x = p01 & m01; pw.y = p23 & m23; pw.z = p01 & ~m01; pw.w = p23 & ~m23; const bf16x8 pf = __builtin_bit_cast(bf16x8, pw); \
            asm volatile(WAITSTR_ : "+v"(lo[bf_][0]), "+v"(hi[bf_][0]), "+v"(lo[bf_][1]), "+v"(hi[bf_][1]), "+v"(lo[bf_][2]), "+v"(hi[bf_][2]), "+v"(lo[bf_][3]), "+v"(hi[bf_][3]) :: "memory"); \
            _Pragma("unroll") for (int dt = 0; dt < 4; ++dt) { const bf16x8 vf = (bf16x8){lo[bf_][dt][0], lo[bf_][dt][1], lo[bf_][dt][2], lo[bf_][dt][3], hi[bf_][dt][0], hi[bf_][dt][1], hi[bf_][dt][2], hi[bf_][dt][3]}; \
                O[dt] = __builtin_amdgcn_mfma_f32_16x16x32_bf16(vf, pf, O[dt], 0, 0, 0); } } while (0)
        NAT_READV(0, 0);
        NAT_READV(1, 1); NAT_PV_ROW(0, 0, "s_waitcnt lgkmcnt(8)"); NAT_READV(0, 2); NAT_PV_ROW(1, 1, "s_waitcnt lgkmcnt(8)"); NAT_READV(1, 3); NAT_PV_ROW(2, 0, "s_waitcnt lgkmcnt(8)");
        NAT_READV(0, 4); NAT_PV_ROW(3, 1, "s_waitcnt lgkmcnt(8)"); NAT_READV(1, 5); NAT_PV_ROW(4, 0, "s_waitcnt lgkmcnt(8)"); NAT_READV(0, 6); NAT_PV_ROW(5, 1, "s_waitcnt lgkmcnt(8)");
        NAT_READV(1, 7); NAT_PV_ROW(6, 0, "s_waitcnt lgkmcnt(8)"); NAT_PV_ROW(7, 1, "s_waitcnt lgkmcnt(0)");
#undef NAT_READV
#undef NAT_PV_ROW
#undef NAT_TR
        asm volatile("" ::: "memory"); __builtin_amdgcn_s_barrier(); asm volatile("" ::: "memory");
        const float il = __builtin_amdgcn_rcpf(l);
        bf16_t* op = ATT + ((size_t)b * SEQ + r * 64 + c) * ATT_LD + h * HD + 4 * q + ((q & 1) ? 12 : 0);
#pragma unroll
        for (int pr2 = 0; pr2 < 2; ++pr2) { const f32x4 o0 = O[2 * pr2] * il, o1 = O[2 * pr2 + 1] * il;
            const auto rx = __builtin_amdgcn_permlane16_swap(g8::cvt_pk_bf16(o0[0], o0[1]), g8::cvt_pk_bf16(o1[0], o1[1]), false, false);
            const auto ry = __builtin_amdgcn_permlane16_swap(g8::cvt_pk_bf16(o0[2], o0[3]), g8::cvt_pk_bf16(o1[2], o1[3]), false, false);
            u32x4 w; w.x = rx[0]; w.y = ry[0]; w.z = rx[1]; w.w = ry[1]; *(u32x4*)(op + 32 * pr2) = w; }
        NAT_DMA_KV(itn, Vg, 65536, voV);
    }
#undef NAT_DMA_KV
#undef NAT_DMA_QB
#undef NAT_PIECE
    asm volatile("s_waitcnt vmcnt(0)" ::: "memory");
    __syncthreads();
}

__device__ __forceinline__ int crow32(int g, int h) { return (g & 3) + 8 * (g >> 2) + 4 * h; }
__device__ __forceinline__ void fft_phase(const Params& p, LAS unsigned char* lds, int G, int bx, int tid, int lane, int wave) {
    unsigned char* ws = p.ws;
    const bf16_t* FT = (const bf16_t*)(ws + WS_FT); bf16_t* PT = (bf16_t*)(ws + WS_PT);
    const int r = lane & 31, h = lane >> 5, kb = wave & 3, chw = wave >> 2, li = lane & 15, qq = li >> 2, pp = li & 3, colhalf = (lane >> 4) & 1;
    LAS unsigned char* tbl = lds + XTRA_OFF + 4096;
    for (int i = tid; i < 27648 / 16; i += NTHR) *(LAS u32x4*)(tbl + 16 * i) = *(const u32x4*)(ws + T_F64 + 16 * i);
    bf16x8 Bc[8], Bs[8];
    { const bf16_t* fc = (const bf16_t*)(ws + T_F128C) + (32 * kb + r) * 128 + 8 * h; const bf16_t* fs = (const bf16_t*)(ws + T_F128S) + (32 * kb + r) * 128 + 8 * h;
#pragma unroll
      for (int ks = 0; ks < 8; ++ks) { Bc[ks] = *(const bf16x8*)(fc + 16 * ks); Bs[ks] = *(const bf16x8*)(fs + 16 * ks); } }
    unsigned twp[2][16];
#pragma unroll
    for (int mt = 0; mt < 2; ++mt)
#pragma unroll
        for (int g = 0; g < 16; ++g) { const int n2 = 32 * mt + crow32(g, h), k1 = 32 * kb + r; const float x = (float)((n2 * k1) & 8191) * (1.f / 8192.f); twp[mt][g] = g8::cvt_pk_bf16(__builtin_amdgcn_cosf(x), __builtin_amdgcn_sinf(x)); }
    __syncthreads();
    const int sw = ((qq >> 1) & 1) << 2;
    u32x4 v[4];
    auto issue = [&](int it2) { const bf16_t* src2 = FT + ((size_t)((it2 / 512) * FW + 2 * (it2 % 512))) * SEQ;
#pragma unroll
        for (int jj = 0; jj < 4; ++jj) v[jj] = *(const u32x4*)(src2 + (size_t)(tid + NTHR * jj) * 8); };
    if (bx < 1536) issue(bx);
    for (int it = bx; it < 1536; it += G) {
        const int b = it / 512, cp = it % 512, ch = 2 * cp + chw;
        __syncthreads();
#pragma unroll
        for (int jj = 0; jj < 4; ++jj) { const int pid = tid + NTHR * jj, chn = pid >> 10, n1 = (pid >> 3) & 127, c8 = pid & 7;
            *(LAS u32x4*)(lds + chn * 16384 + n1 * 128 + ((c8 ^ (((n1 >> 1) & 1) << 2)) << 4)) = v[jj]; }
        __syncthreads();
        if (it + G < 1536) issue(it + G);
        int frep_ = FFT_REP; asm volatile("" : "+s"(frep_));
        for (int rep_ = 0; rep_ < frep_; ++rep_) {
        f32x16 a1r[2], a1i[2];
#pragma unroll
        for (int mt = 0; mt < 2; ++mt)
#pragma unroll
            for (int g = 0; g < 16; ++g) { a1r[mt][g] = 0.f; a1i[mt][g] = 0.f; }
        {
            unsigned fa_[2];
#pragma unroll
            for (int mt = 0; mt < 2; ++mt) { const int c8 = 4 * mt + 2 * colhalf + (pp >> 1); fa_[mt] = (unsigned)(size_t)lds + chw * 16384 + (8 * h + qq) * 128 + ((c8 ^ sw) << 4) + (pp & 1) * 8; }
            v4i16_t lo[3][2], hi[3][2];
#define FFT_TR(d_, a_, off_) asm volatile("ds_read_b64_tr_b16 %0, %1 offset:%2" : "=v"(d_) : "v"(a_), "n"(off_) : "memory")
#define FFT_RD1(bf_, ks_) do { FFT_TR(lo[bf_][0], fa_[0], (ks_) * 2048); FFT_TR(hi[bf_][0], fa_[0], (ks_) * 2048 + 512); FFT_TR(lo[bf_][1], fa_[1], (ks_) * 2048); FFT_TR(hi[bf_][1], fa_[1], (ks_) * 2048 + 512); } while (0)
#define FFT_ST1(bf_, ks_, WAITSTR_) do { asm volatile(WAITSTR_ : "+v"(lo[bf_][0]), "+v"(hi[bf_][0]), "+v"(lo[bf_][1]), "+v"(hi[bf_][1]) :: "memory"); \
                _Pragma("unroll") for (int mt = 0; mt < 2; ++mt) { const bf16x8 A = (bf16x8){lo[bf_][mt][0], lo[bf_][mt][1], lo[bf_][mt][2], lo[bf_][mt][3], hi[bf_][mt][0], hi[bf_][mt][1], hi[bf_][mt][2], hi[bf_][mt][3]}; \
                    a1r[mt] = __builtin_amdgcn_mfma_f32_32x32x16_bf16(A, Bc[ks_], a1r[mt], 0, 0, 0); a1i[mt] = __builtin_amdgcn_mfma_f32_32x32x16_bf16(A, Bs[ks_], a1i[mt], 0, 0, 0); } } while (0)
            FFT_RD1(0, 0); FFT_RD1(1, 1);
            FFT_RD1(2, 2); FFT_ST1(0, 0, "s_waitcnt lgkmcnt(8)"); FFT_RD1(0, 3); FFT_ST1(1, 1, "s_waitcnt lgkmcnt(8)"); FFT_RD1(1, 4); FFT_ST1(2, 2, "s_waitcnt lgkmcnt(8)");
            FFT_RD1(2, 5); FFT_ST1(0, 3, "s_waitcnt lgkmcnt(8)"); FFT_RD1(0, 6); FFT_ST1(1, 4, "s_waitcnt lgkmcnt(8)"); FFT_RD1(1, 7); FFT_ST1(2, 5, "s_waitcnt lgkmcnt(8)");
            FFT_ST1(0, 6, "s_waitcnt lgkmcnt(4)"); FFT_ST1(1, 7, "s_waitcnt lgkmcnt(0)");
#undef FFT_ST1
#undef FFT_RD1
#undef FFT_TR
        }
        if (kb == 0) {
            float sg = 0.f;
#pragma unroll
            for (int mt = 0; mt < 2; ++mt)
#pragma unroll
                for (int g = 0; g < 16; ++g) sg += (g & 1) ? -a1r[mt][g] : a1r[mt][g];
            sg = xsum32(sg);
            if (lane == 0) ((float*)(ws + T_P4096))[b * FW + ch] = sg;
        }
        bf16x8 Br[2][2], Bi[2][2];
#pragma unroll
        for (int mt = 0; mt < 2; ++mt)
#pragma unroll
            for (int s = 0; s < 2; ++s) { u32x4 wr_, wi_;
#pragma unroll
                for (int e2 = 0; e2 < 4; ++e2) { const int g0 = 8 * s + 2 * e2, g1 = g0 + 1;
                    unsigned w0 = twp[mt][g0], w1 = twp[mt][g1]; asm volatile("" : "+v"(w0), "+v"(w1));
                    const float c0 = __uint_as_float(w0 << 16), s0_ = __uint_as_float(w0 & 0xffff0000u), c1 = __uint_as_float(w1 << 16), s1_ = __uint_as_float(w1 & 0xffff0000u);
                    const float xr0 = a1r[mt][g0] * c0 + a1i[mt][g0] * s0_, xi0 = a1i[mt][g0] * c0 - a1r[mt][g0] * s0_;
                    const float xr1 = a1r[mt][g1] * c1 + a1i[mt][g1] * s1_, xi1 = a1i[mt][g1] * c1 - a1r[mt][g1] * s1_;
                    wr_[e2] = g8::cvt_pk_bf16(xr0, xr1); wi_[e2] = g8::cvt_pk_bf16(xi0, xi1); }
                Br[mt][s] = __builtin_bit_cast(bf16x8, wr_); Bi[mt][s] = __builtin_bit_cast(bf16x8, wi_); }
        LAS unsigned char* stg = lds + 65536 + wave * 8192;
#pragma unroll
        for (int mt2 = 0; mt2 < 1; ++mt2) {
            f32x16 pr, pi;
#pragma unroll
            for (int g = 0; g < 16; ++g) { pr[g] = 0.f; pi[g] = 0.f; }
#pragma unroll
            for (int q4 = 0; q4 < 4; ++q4) { const int off = (32 * mt2 + r) * 144 + (q4 * 16 + 8 * h) * 2;
                bf16x8 Cf = *(const LAS bf16x8*)(tbl + off), Sf = *(const LAS bf16x8*)(tbl + 9216 + off), NSf = *(const LAS bf16x8*)(tbl + 18432 + off);
                asm volatile("" : "+v"(Cf), "+v"(Sf), "+v"(NSf));
                pr = __builtin_amdgcn_mfma_f32_32x32x16_bf16(Cf, Br[q4 >> 1][q4 & 1], pr, 0, 0, 0);
                pr = __builtin_amdgcn_mfma_f32_32x32x16_bf16(Sf, Bi[q4 >> 1][q4 & 1], pr, 0, 0, 0);
                pi = __builtin_amdgcn_mfma_f32_32x32x16_bf16(Cf, Bi[q4 >> 1][q4 & 1], pi, 0, 0, 0);
                pi = __builtin_amdgcn_mfma_f32_32x32x16_bf16(NSf, Br[q4 >> 1][q4 & 1], pi, 0, 0, 0); }
#pragma unroll
            for (int g = 0; g < 16; ++g) { const int row = 32 * mt2 + crow32(g, h);
                *(LAS bf16_t*)(stg + row * 64 + r * 2) = (bf16_t)(g8::cvt_pk_bf16(pr[g], pr[g]) & 0xffffu);
                *(LAS bf16_t*)(stg + 4096 + row * 64 + r * 2) = (bf16_t)(g8::cvt_pk_bf16(pi[g], pi[g]) & 0xffffu); }
        }
#pragma unroll
        for (int part = 0; part < 2; ++part)
#pragma unroll
            for (int st = 0; st < 2; ++st) { const int row = st * 16 + (lane >> 2), c4 = lane & 3;
                const u32x4 w = *(const LAS u32x4*)(stg + part * 4096 + row * 64 + c4 * 16);
                *(u32x4*)(PT + ((size_t)((b * 2 + part) * FW + ch)) * SEQ + 128 * row + 32 * kb + 8 * c4) = w; }
        }
    }
    __syncthreads();
}
__device__ __forceinline__ void ph_inproj(const Params& p, LAS unsigned char* lds, int G, int bx) {
    unsigned char* ws = p.ws;
    { typedef SchedP1 SG; SG S{(const char*)(ws + WS_XB), (const char*)(ws + WS_WIN), G, bx};
      if (threadIdx.x < 128) ((LAS float*)(lds + XTRA_OFF + 16384))[threadIdx.x] = threadIdx.x < 64 ? p.q_norm[threadIdx.x] : p.k_norm[threadIdx.x - 64];
      __syncthreads();
      EpiP1 E{ws, (bf16_t*)p.out, lds + XTRA_OFF};
      g8::gemm_phase<EpiP1, SG, D, D, true, KREP_[1]>(lds, S, E); }
}
__device__ __forceinline__ void ph_chdft(const Params& p, LAS unsigned char* lds, int G, int bx, int tid) {
    unsigned char* ws = p.ws;
    if (bx >= 244) {
        const int j = bx - 244, b = j >> 2, g = j & 3, c8 = tid & 31, cr = tid >> 5;
        const float* P4 = (const float*)(ws + T_P4096) + b * FW + g * 256 + cr * 16; const bf16_t* Tc = (const bf16_t*)(ws + T_DFTC) + (size_t)cr * 16 * 256 + 8 * c8;
        f32x4 s0 = {0.f, 0.f, 0.f, 0.f}, s1 = {0.f, 0.f, 0.f, 0.f};
#pragma unroll
        for (int q = 0; q < 16; ++q) { const float pv = P4[q]; const u32x4 w = *(const u32x4*)(Tc + q * 256); s0 += pv * bf_lo4(w, 0); s1 += pv * bf_lo4(w, 1); }
        LAS float* red = (LAS float*)lds;
        *(LAS f32x4*)(red + cr * 256 + 8 * c8) = s0; *(LAS f32x4*)(red + cr * 256 + 8 * c8 + 4) = s1;
        __syncthreads();
        if (tid < 256) { float t = 0.f;
#pragma unroll
            for (int q = 0; q < 16; ++q) t += red[q * 256 + tid];
            ((bf16_t*)(ws + WS_Y))[((size_t)b * SEQ + 4096) * FW + g * 256 + tid] = f2bf(t); }
        __syncthreads();
    }
    SchedChDft S{(const char*)(ws + WS_PT), (const char*)(ws + T_CS), G, bx};
    EpiChDft E{(bf16_t*)(ws + WS_Y)};
    g8::gemm_phase<EpiChDft, SchedChDft, SEQ, 512, false, 1, true>(lds, S, E);
}
__device__ __forceinline__ void ph_merge(const Params& p, LAS unsigned char* lds, int G, int bx) {
    unsigned char* ws = p.ws;
    SchedMerge2 S{(const char*)(ws + WS_Y), (const char*)(ws + WS_ATT), (const char*)(ws + WS_WFO), (const char*)(ws + WS_WAO), G, bx};
    EpiMergeBr E{EpiMerge{ws, (const bf16_t*)p.out}};
    g8::gemm_phase<EpiMergeBr, SchedMerge2, 1024, 1024, false, KREP_[4], false>(lds, S, E);
}
__device__ __forceinline__ void ph_outproj(const Params& p, LAS unsigned char* lds, int G, int bx) {
    unsigned char* ws = p.ws;
    typedef SchedGrid<M / 256, D / 256, D / 64, D, D> SG; SG S{(const char*)(ws + WS_MERGED), (const char*)(ws + WS_WOUT), G, bx};
    EpiX1 E{XIn{p.xp, p.xs}, ws};
    g8::gemm_phase<EpiX1, SG, D, D, false, KREP_[5]>(lds, S, E);
}
__device__ __forceinline__ void ph_up(const Params& p, LAS unsigned char* lds, int G, int bx, int vcu, int tid) {
    unsigned char* ws = p.ws;
    {
        const float* SSQ = (const float*)(ws + WS_SSQ); float* r2 = (float*)(ws + T_RSTD2);
        for (int r = vcu * NTHR + tid; r < M; r += G * NTHR) { const f32x4* q = (const f32x4*)(SSQ + (size_t)r * 32); float s = 0.f;
#pragma unroll
            for (int j = 0; j < 8; ++j) { const f32x4 v = q[j]; s += (v[0] + v[1]) + (v[2] + v[3]); }
            r2[r] = 1.f / (s * (1.f / D) + EPS); }
    }
    typedef SchedGrid<M / 256, DFF / 256, D / 64, D, D> SG; SG S{(const char*)(ws + WS_X1B), (const char*)(ws + WS_W1), G, bx};
    EpiRelu2 E{(bf16_t*)(ws + WS_U), (bf16_t*)p.out};
    g8::gemm_phase<EpiRelu2, SG, D, D, false, KREP_[6]>(lds, S, E);
}
__device__ __forceinline__ void ph_down(const Params& p, LAS unsigned char* lds, int G, int bx) {
    unsigned char* ws = p.ws;
    SchedDown S{(const char*)(ws + WS_U), (const char*)p.out, (const char*)(ws + WS_W2), G, bx};
    EpiDown E{p.out, ws, (unsigned*)(ws + WS_CTL) + CW_PANEL};
    g8::gemm_phase<EpiDown, SchedDown, 4096, DFF, false, KREP_[7]>(lds, S, E);
}

__global__ void __launch_bounds__(NTHR, 2) __attribute__((target("no-packed-fp32-ops"))) mk_fwd(Params p) {
    extern __shared__ __attribute__((aligned(16))) unsigned char lds_raw[];
    LAS unsigned char* lds = (LAS unsigned char*)lds_raw;
    const int tid = threadIdx.x, lane = tid & 63, wave = __builtin_amdgcn_readfirstlane(tid >> 6);
    const int G = gridDim.x, bx = blockIdx.x;
    const int vcu = (G % 8 == 0) ? (bx % 8) * (G / 8) + bx / 8 : bx;
    const int gw = vcu * NWAVES + wave, NGW = G * NWAVES;
    unsigned char* ws = p.ws;
    volatile LAS unsigned* MISC = (volatile LAS unsigned*)(lds + LDSCTL_OFF);
    if (tid < 64) MISC[tid] = 0u;
    __syncthreads();
    unsigned* ctl = (unsigned*)(ws + WS_CTL);
    XcdBarrier bar = xcd_barrier_post(ctl + CW_BAR + p.li * XCD_BAR_WORDS, MISC + 8);
    const int lo = p.ph_lo, hi = p.ph_hi;
#define IN(k) (lo <= (k) && (k) < hi)
#define SEAM(k) do { if (IN(k) && IN((k) + 1)) xcd_barrier(bar); } while (0)

#define PHASE(k, body) do { if (IN(k)) { body; } SEAM(k); } while (0)
    PHASE(0, p0_prologue(p, lds, gw, NGW, lane, wave));
    PHASE(1, ph_inproj(p, lds, G, bx));
    PHASE(2, { const bool fft_first = bx & 1;     if (!fft_first) natten_phase(p, lds, G, vcu, tid, lane, wave); fft_phase(p, lds, G, bx, tid, lane, wave); if (fft_first) natten_phase(p, lds, G, vcu, tid, lane, wave); });
    PHASE(3, ph_chdft(p, lds, G, bx, tid));
    PHASE(4, ph_merge(p, lds, G, bx));
    PHASE(5, ph_outproj(p, lds, G, bx));
    PHASE(6, ph_up(p, lds, G, bx, vcu, tid));
    PHASE(7, ph_down(p, lds, G, bx));
#ifdef MK_PROBE_SUBPHASES
    if (IN(8)) { fft_phase(p, lds, G, bx, tid, lane, wave); }
    if (IN(9)) { natten_phase(p, lds, G, bx, tid, lane, wave); }
#endif
#undef PHASE
#undef IN
#undef SEAM
}

extern "C" void kernel_launch(void* const* d_in, const int* in_sizes, int n_in, void* d_out, int out_size, void* d_ws, size_t ws_size, hipStream_t stream) {
    static int grid = 0;
    if (grid == 0) {
        if (n_in != 13 || ws_size < WS_END || out_size != M * D) { fprintf(stderr, "kernel_launch: unexpected sizes n_in %d ws %zu out %d\n", n_in, ws_size, out_size); grid = -1; return; }
        int dev = 0, cus = 0, per_cu = 0;
        if (hipGetDevice(&dev) != hipSuccess || hipDeviceGetAttribute(&cus, hipDeviceAttributeMultiprocessorCount, dev) != hipSuccess) { grid = -1; return; }
        if (hipFuncSetAttribute((const void*)mk_fwd, hipFuncAttributeMaxDynamicSharedMemorySize, LDS_BYTES) != hipSuccess) { fprintf(stderr, "kernel_launch: hipFuncSetAttribute failed\n"); grid = -1; return; }
        if (hipOccupancyMaxActiveBlocksPerMultiprocessor(&per_cu, (const void*)mk_fwd, NTHR, LDS_BYTES) != hipSuccess || per_cu < 1) fprintf(stderr, "kernel_launch: occupancy query says %d\n", per_cu);
        (void)hipGetLastError();
        grid = cus;
        if (grid != 256) { fprintf(stderr, "kernel_launch: built for a 256-CU device (MI355X), found %d CUs; nothing launched\n", cus); grid = -1; return; }
    }
    if (grid < 0) return;
    const float* xp = (const float*)d_in[0]; const float* xs = (const float*)d_in[1];
    const float* g_mix = (const float*)d_in[2]; const float* w_in = (const float*)d_in[3];
    const float* q_norm = (const float*)d_in[4]; const float* k_norm = (const float*)d_in[5]; const float* rpb = (const float*)d_in[6];
    const float* w_fo = (const float*)d_in[7]; const float* w_ao = (const float*)d_in[8]; const float* w_out = (const float*)d_in[9];
    const float* g_mlp = (const float*)d_in[10]; const float* w1 = (const float*)d_in[11]; const float* w2 = (const float*)d_in[12];
    unsigned char* ws = (unsigned char*)d_ws; float* out = (float*)d_out;

    hipMemsetAsync(ws + WS_CTL, 0, CTL_ZERO_BYTES, stream);
    Params prm{}; prm.xp = xp; prm.xs = xs; prm.g_mix = g_mix; prm.w_in = w_in; prm.q_norm = q_norm; prm.k_norm = k_norm; prm.rpb = rpb; prm.w_fo = w_fo; prm.w_ao = w_ao; prm.w_out = w_out;
    prm.g_mlp = g_mlp; prm.w1 = w1; prm.w2 = w2; prm.out = out; prm.ws = ws;
    int n_mk = 0;
#define MK(lo_, hi_) do { prm.ph_lo = lo_; prm.ph_hi = hi_; prm.li = n_mk++; hipLaunchKernelGGL(mk_fwd, dim3(grid), dim3(NTHR), LDS_BYTES, stream, prm); } while (0)
    constexpr int PLAN[][2] = {{0, 8}};
    for (auto& pl : PLAN) MK(pl[0], pl[1]);
}
```

```cpp
#include <hip/hip_runtime.h>
#include <cstdio>
#include <cstdint>

typedef unsigned short bf16_t;
typedef short bf16x8 __attribute__((ext_vector_type(8)));
typedef short s16x4 __attribute__((ext_vector_type(4)));
typedef float f32x2 __attribute__((ext_vector_type(2)));
typedef float f32x4 __attribute__((ext_vector_type(4)));
typedef float f32x16 __attribute__((ext_vector_type(16)));
typedef unsigned u32x2 __attribute__((ext_vector_type(2)));
typedef unsigned u32x4 __attribute__((ext_vector_type(4)));
#define LAS __attribute__((address_space(3)))
#define GAS __attribute__((address_space(1)))

constexpr int D = 2048, SEQ = 8192, NB = 3, M = NB * SEQ;
constexpr int NH = 16, HD = 64, AW = 1024, FW = 1024, INW = 8192, DFF = 8192;
constexpr float EPS = 1e-6f;
constexpr float LOG2E = 1.4426950408889634f;
constexpr float QSCALE = 0.125f * LOG2E;
constexpr float S_ORTHO = 6.905339660024878e-4f;

constexpr size_t MiB = 1u << 20;
constexpr size_t WS_CTL = 0, CTL_ZERO_BYTES = 65536;
constexpr size_t WS_TAB = 1 * MiB;
constexpr size_t T_RSTD1 = WS_TAB, T_RSTD2 = WS_TAB + 98304;
constexpr size_t T_DFTC = WS_TAB + 196608, T_DFTS = WS_TAB + 327680;
constexpr size_t T_F128C = WS_TAB + 458752, T_F128S = WS_TAB + 491520;
constexpr size_t T_F64 = WS_TAB + 524288;
constexpr size_t T_RPB = WS_TAB + 557056;
constexpr size_t T_TW = WS_TAB + 589824;
constexpr size_t T_CS = WS_TAB + 1048576;
constexpr size_t T_P4096 = WS_TAB + 1048576 + 524288;
constexpr size_t WS_SSQ = 3 * MiB;
constexpr size_t WS_WIN = 6 * MiB, WS_WFO = 38 * MiB, WS_WAO = 42 * MiB, WS_WOUT = 54 * MiB, WS_W1 = 62 * MiB, WS_W2 = 94 * MiB;
constexpr size_t WS_B = 126 * MiB, WS_Q = WS_B, WS_K = WS_B + 48 * MiB, WS_V = WS_B + 96 * MiB, WS_MERGED = WS_B;
constexpr size_t WS_A = 270 * MiB, WS_XB = WS_A, WS_PT = WS_A;
constexpr size_t WS_C = 366 * MiB, WS_FT = WS_C, WS_FM = WS_C;
constexpr size_t WS_D = 414 * MiB, WS_ATT = WS_D, WS_X1B = WS_D;
constexpr size_t WS_U = 126 * MiB;
constexpr size_t WS_TMP0 = 6 * MiB, WS_TMP1 = 318 * MiB;
constexpr size_t WS_END = 510 * MiB;
constexpr int ATT_LD = 1024;
constexpr size_t WS_Y = 366 * MiB;

__device__ __forceinline__ float bf2f(bf16_t v) { return __uint_as_float((unsigned)v << 16); }
__device__ __forceinline__ bf16_t f2bf(float f) { unsigned u = __float_as_uint(f); return (bf16_t)((u + 0x7fffu + ((u >> 16) & 1u)) >> 16); }
__device__ __forceinline__ unsigned pk2(float lo, float hi) { return (unsigned)f2bf(lo) | ((unsigned)f2bf(hi) << 16); }

struct XIn { const float* xp; const float* xs; __device__ __forceinline__ const float* row(int m) const { return m < SEQ ? xp + (size_t)m * D : xs + (size_t)(m - SEQ) * D; } };

namespace g8 {
constexpr int BM = 256, BK = 64, HALF = 128, HTB = HALF * BK * 2, STAGE_BYTES = 8 * HTB, NXCD = 8, WGM = 4;

__host__ __device__ __forceinline__ int lds_byte(int r, int c) { const int st = (r >> 4) * 2 + (c >> 5), rr = r & 15, cc = c & 31, ob = rr * 64 + cc * 2; return st * 1024 + (ob ^ (((ob >> 9) & 1) << 5)); }
__host__ __device__ __forceinline__ void stage_rc(int b, int& R, int& C) { const int st = b / 1024, sb = b % 1024, swz = sb ^ (((sb >> 9) & 1) << 5); R = (st >> 1) * 16 + swz / 64; C = (st & 1) * 32 + (swz % 64) / 2; }
__host__ __device__ __forceinline__ int perm32(int rho) { const int n = rho >> 4, i = rho & 15; return 8 * (i >> 2) + 4 * n + (i & 3); }

struct Unit { const char* a; const char* b; int pm, pn, nt, keep, br; };

template <int WG = WGM> __device__ __forceinline__ void tile_of(int L, int nM, int nN, int& pm, int& pn) {
    const int nwg = nM * nN; int wgid = L;
    { const int q = nwg / NXCD, r = nwg % NXCD, xcd = wgid % NXCD, off = wgid / NXCD; wgid = (xcd < r ? xcd * (q + 1) : r * (q + 1) + (xcd - r) * q) + off; }
    const int nig = WG * nN, gid = wgid / nig, fm = gid * WG, gsz = (nM - fm) < WG ? (nM - fm) : WG;
    pm = fm + ((wgid % nig) % gsz); pn = (wgid % nig) / gsz;
}

typedef __bf16 bf16x2_t __attribute__((ext_vector_type(2)));
__device__ __forceinline__ unsigned cvt_pk_bf16(float lo, float hi) { f32x2 v = {lo, hi}; bf16x2_t b = __builtin_convertvector(v, bf16x2_t); return __builtin_bit_cast(unsigned, b); }

template <bool HEAD64> __device__ __forceinline__ int colbase(int bj, int wc, int fq) { return HEAD64 ? (64 * wc + 32 * bj + 8 * fq) : (128 * bj + 32 * wc + 8 * fq); }

template <class Epi, class Sched, int lda, int ldb, bool HEAD64, int KREP = 1, bool AKM = false>
__device__ __forceinline__ void gemm_phase(LAS unsigned char* lds, const Sched& S, const Epi& E) {
    const int tid = threadIdx.x, wid = __builtin_amdgcn_readfirstlane(tid >> 6), lane = tid & 63, wr = wid >> 2, wc = wid & 3, fr = lane & 15, fq = lane >> 4;
    Unit cur, nxt; int ui = 0; bool prev_keep = false;
    if (!S.next(0, cur)) return;
    unsigned voffB[2], voffA[2];
#pragma unroll
    for (int i = 0; i < 2; ++i) { int R, C; stage_rc(tid * 16 + i * 8192, R, C);
        const int Rb = HEAD64 ? ((R >> 5) * 64 + perm32(R & 31)) : ((R & ~31) + perm32(R & 31));
        voffB[i] = (unsigned)(Rb * ldb + C) * 2u; voffA[i] = (unsigned)(R * lda + C) * 2u;
        if (AKM) { const int pb = tid * 16 + i * 8192, krow = pb >> 8, c16s = (pb >> 4) & 15, f = (krow & 3) | (((krow >> 3) & 1) << 2), c16 = (((c16s >> 1) ^ f) << 1) | (c16s & 1);
            voffA[i] = (unsigned)(krow * lda + c16 * 8) * 2u; } }
    const size_t kstep = (size_t)(BK * 2), kstepA = AKM ? (size_t)BK * lda * 2 : kstep;
    const size_t hB = (size_t)(HEAD64 ? 32 : HALF) * ldb * 2;
    const size_t hA = AKM ? (size_t)HALF * 2 : (size_t)HALF * lda * 2;
    const int akoff = ((8 * fq + (fr >> 2)) << 8) + 8 * (fr & 3), akf = (fr >> 2) | ((fq & 1) << 2);
    const unsigned ldsw = (unsigned)wid * 1024u;
    const int aoff = lds_byte(wr * 64 + fr, fq * 8), boff = lds_byte(wc * 32 + fr, fq * 8);
#define G8_SA(b, h) (((b) * 2 + (h)) * HTB)
#define G8_SB(b, h) ((4 + (b) * 2 + (h)) * HTB)
#define G8_STAGE(bufoff, gbase, voff) do { const char* sb_ = (const char*)(gbase); asm volatile("" : "+s"(sb_));     \
        _Pragma("unroll") for (int _i = 0; _i < 2; ++_i) { unsigned vo_ = (voff)[_i]; asm volatile("" : "+v"(vo_));     \
        __builtin_amdgcn_global_load_lds((const unsigned*)(sb_ + vo_), (LAS unsigned*)(lds + (bufoff) + ldsw + _i * 8192), 16, 0, 0); } } while (0)
#define G8_TR(d_, a_, off_) asm volatile("ds_read_b64_tr_b16 %0, %1 offset:%2" : "=v"(d_) : "v"(a_), "n"(off_) : "memory")
#define G8_PINA do { if constexpr (AKM) asm volatile("s_waitcnt lgkmcnt(0)" : "+v"(At[0][0]), "+v"(At[0][1]), "+v"(At[1][0]), "+v"(At[1][1]), "+v"(At[2][0]), "+v"(At[2][1]), "+v"(At[3][0]), "+v"(At[3][1]) :: "memory"); } while (0)
#define G8_LDA(dst, b, h) do { if constexpr (!AKM) { _Pragma("unroll") for (int m = 0; m < 4; ++m) _Pragma("unroll") for (int k = 0; k < 2; ++k) dst[m][k] = *(const LAS bf16x8*)(lds + G8_SA(b, h) + aoff + m * 2048 + k * 1024); } \
    else { _Pragma("unroll") for (int m = 0; m < 4; ++m) { const unsigned ab_ = (unsigned)(size_t)lds + (unsigned)(akoff + (((4 * wr + m) ^ akf) << 5)); s16x4 l0_, h0_, l1_, h1_; \
        G8_TR(l0_, ab_, G8_SA(b, h)); G8_TR(h0_, ab_, G8_SA(b, h) + 1024); G8_TR(l1_, ab_, G8_SA(b, h) + 8192); G8_TR(h1_, ab_, G8_SA(b, h) + 8192 + 1024); \
        dst[m][0] = (bf16x8){l0_[0], l0_[1], l0_[2], l0_[3], h0_[0], h0_[1], h0_[2], h0_[3]}; dst[m][1] = (bf16x8){l1_[0], l1_[1], l1_[2], l1_[3], h1_[0], h1_[1], h1_[2], h1_[3]}; } } } while (0)
#define G8_LDB(dst, b, h) do { _Pragma("unroll") for (int n = 0; n < 2; ++n) _Pragma("unroll") for (int k = 0; k < 2; ++k) dst[n][k] = *(const LAS bf16x8*)(lds + G8_SB(b, h) + boff + n * 2048 + k * 1024); } while (0)
#define G8_MMA(ai, bj, At, Bt) do { __builtin_amdgcn_s_setprio(1); _Pragma("unroll") for (int m = 0; m < 4; ++m) _Pragma("unroll") for (int n = 0; n < 2; ++n) _Pragma("unroll") for (int k = 0; k < 2; ++k) \
        acc[ai][bj][m][n] = __builtin_amdgcn_mfma_f32_16x16x32_bf16(Bt[n][k], At[m][k], acc[ai][bj][m][n], 0, 0, 0); __builtin_amdgcn_s_setprio(0); } while (0)
#define G8_WAIT_V(n) asm volatile("s_waitcnt vmcnt(" #n ")" ::: "memory")
#define G8_WAIT_L(n) asm volatile("s_waitcnt lgkmcnt(" #n ")" ::: "memory")
#define G8_BAR __builtin_amdgcn_s_barrier()
#define G8_SCHED __builtin_amdgcn_sched_barrier(0)
    f32x4 acc[2][2][4][2];
#pragma unroll
    for (int a = 0; a < 2; ++a)
#pragma unroll
        for (int b = 0; b < 2; ++b)
#pragma unroll
            for (int m = 0; m < 4; ++m)
#pragma unroll
                for (int n = 0; n < 2; ++n) acc[a][b][m][n] = (f32x4){0.f, 0.f, 0.f, 0.f};
    bf16x8 At[4][2], B0[2][2], B1[2][2];
    const char* cA = cur.a; const char* cB = cur.b;
    G8_STAGE(G8_SB(0, 0), cB, voffB); G8_STAGE(G8_SB(0, 1), cB + hB, voffB); G8_STAGE(G8_SA(0, 0), cA, voffA); G8_STAGE(G8_SA(0, 1), cA + hA, voffA);
    if (wr == 1) G8_BAR;
    G8_WAIT_V(2); G8_BAR;
    G8_STAGE(G8_SB(1, 0), cB + kstep, voffB); G8_STAGE(G8_SA(1, 0), cA + kstepA, voffA); G8_STAGE(G8_SB(1, 1), cB + hB + kstep, voffB);
    G8_WAIT_V(6); G8_BAR;
    for (;;) {
        const bool has_next = S.next(ui + 1, nxt);
        const char* nA = has_next ? nxt.a : cA; const char* nB = has_next ? nxt.b : cB;
        const int nt1 = cur.nt, nt = nt1 * KREP;
        for (int t = 0; t < nt; t += 2) {
            const bool last = (t == nt - 2);
            const int t1 = (KREP > 1 && t + 1 >= nt1) ? t + 1 - nt1 : t + 1, t2 = (KREP > 1 && t + 2 >= nt1) ? t + 2 - nt1 : t + 2;
            const char* a1 = cA + (size_t)t1 * kstepA;
            const char* a2 = last ? nA : cA + (size_t)t2 * kstepA; const char* b2 = last ? nB : cB + (size_t)t2 * kstep;
            const char* a3 = a2 + kstepA; const char* b3 = b2 + kstep;
            const bool relax = (t == 0) && (ui > 0) && !(Sched::HAS_KEEP && prev_keep);
            G8_LDB(B0, 0, 0); G8_LDB(B1, 0, 1); G8_SCHED; G8_LDA(At, 0, 0); G8_STAGE(G8_SA(1, 1), a1 + hA, voffA);
            if (relax) G8_WAIT_V(24); else G8_WAIT_V(8);
            G8_WAIT_L(0); G8_PINA; G8_BAR; G8_MMA(0, 0, At, B0); G8_MMA(0, 1, At, B1); G8_BAR; G8_SCHED;
            G8_LDA(At, 0, 1); G8_STAGE(G8_SB(0, 0), b2, voffB); G8_STAGE(G8_SB(0, 1), b2 + hB, voffB); G8_STAGE(G8_SA(0, 0), a2, voffA);
            if (relax) G8_WAIT_V(24); else G8_WAIT_V(8);
            G8_WAIT_L(0); G8_PINA; G8_BAR; G8_MMA(1, 0, At, B0); G8_MMA(1, 1, At, B1); G8_BAR; G8_SCHED;
            G8_LDB(B0, 1, 0); G8_LDB(B1, 1, 1); G8_SCHED; G8_LDA(At, 1, 0); G8_STAGE(G8_SA(0, 1), a2 + hA, voffA);
            G8_WAIT_V(8); G8_WAIT_L(0); G8_PINA; G8_BAR; G8_MMA(0, 0, At, B0); G8_MMA(0, 1, At, B1); G8_BAR; G8_SCHED;
            G8_LDA(At, 1, 1); G8_STAGE(G8_SB(1, 0), b3, voffB); G8_STAGE(G8_SB(1, 1), b3 + hB, voffB); G8_STAGE(G8_SA(1, 0), a3, voffA);
            G8_WAIT_V(8); G8_WAIT_L(0); G8_PINA; G8_BAR; G8_MMA(1, 0, At, B0); G8_MMA(1, 1, At, B1); G8_BAR; G8_SCHED;
        }
        if (wr == 0) G8_BAR;
        if (KREP > 1) {
#pragma unroll
            for (int a = 0; a < 2; ++a)
#pragma unroll
                for (int b = 0; b < 2; ++b)
#pragma unroll
                    for (int m = 0; m < 4; ++m)
#pragma unroll
                        for (int n = 0; n < 2; ++n) acc[a][b][m][n] *= (1.f / KREP); }
        E(acc, cur, wr, wc, fr, fq);
        if (!has_next) break;
        if constexpr (Sched::HAS_KEEP) prev_keep = cur.keep != 0;
        if (!(Sched::HAS_KEEP && prev_keep)) {
#pragma unroll
        for (int a = 0; a < 2; ++a)
#pragma unroll
            for (int b = 0; b < 2; ++b)
#pragma unroll
                for (int m = 0; m < 4; ++m)
#pragma unroll
                    for (int n = 0; n < 2; ++n) acc[a][b][m][n] = (f32x4){0.f, 0.f, 0.f, 0.f};
        }
        cur = nxt; cA = nA; cB = nB; ++ui;
        if (wr == 1) G8_BAR;
    }
    G8_WAIT_V(0);
    G8_BAR;
#undef G8_SA
#undef G8_SB
#undef G8_STAGE
#undef G8_LDA
#undef G8_TR
#undef G8_PINA
#undef G8_LDB
#undef G8_MMA
#undef G8_WAIT_V
#undef G8_WAIT_L
#undef G8_BAR
#undef G8_SCHED
}
}

#define XB_TMO      128
#define XB_XCNT(j)  (256  + 64 * (j))
#define XB_XSUB(j)  (1280 + 64 * (j))
#define XB_XGEN(j)  (2304 + 64 * (j))
#define XB_TOP      3328
#define XB_TOPGEN   3392
#define XCD_BAR_WORDS 3456
#define XB_SPIN_CAP (1u << 18)

__device__ __forceinline__ unsigned xb_ld(unsigned* p)              { return __hip_atomic_load(p, __ATOMIC_RELAXED, __HIP_MEMORY_SCOPE_AGENT); }
__device__ __forceinline__ unsigned xb_add(unsigned* p, unsigned v) { return __hip_atomic_fetch_add(p, v, __ATOMIC_RELAXED, __HIP_MEMORY_SCOPE_AGENT); }
__device__ __forceinline__ unsigned xb_xcc_id() { return (unsigned)__builtin_amdgcn_s_getreg((3 << 11) | 20) & 0xFu; }
#define XB_SPIN(cond, bar) do { unsigned _sp = 0; while (cond) { __builtin_amdgcn_s_sleep(1); \
    if ((++_sp & 255u) == 0u) { if (xb_ld(&(bar)[XB_TMO])) break; if (_sp > XB_SPIN_CAP) { atomicAdd(&(bar)[XB_TMO], 1u); break; } } } } while (0)

struct XcdBarrier { unsigned* bar; unsigned x; volatile LAS unsigned* st; };

__device__ __forceinline__ XcdBarrier xcd_barrier_post(unsigned* bar, volatile LAS unsigned* st) {
    XcdBarrier b; b.bar = bar; b.x = xb_xcc_id(); b.st = st;
    if (threadIdx.x == 0) (void)xb_add(&bar[XB_XCNT(b.x)], 1u);
    return b;
}
__device__ __forceinline__ void xcd_barrier_complete(unsigned* bar, unsigned x, unsigned& nloc, unsigned& nx) {
    const unsigned G = gridDim.x * gridDim.y * gridDim.z;
    unsigned sum, cnt, mine, sp = 0u;
    for (;;) {
        sum = 0u; cnt = 0u; mine = 0u;
#pragma unroll
        for (unsigned j = 0; j < 16; ++j) { const unsigned c = xb_ld(&bar[XB_XCNT(j)]); sum += c; cnt += (c > 0u) ? 1u : 0u; mine = (j == x) ? c : mine; }
        if (sum == G) break;
        __builtin_amdgcn_s_sleep(1);
        if ((++sp & 255u) == 0u) { if (xb_ld(&bar[XB_TMO])) break; if (sp > XB_SPIN_CAP) { atomicAdd(&bar[XB_TMO], 1u); break; } }
    }
    nloc = mine > 0u ? mine : 1u; nx = cnt > 0u ? cnt : 1u;
}
__device__ __forceinline__ void xcd_barrier(const XcdBarrier& b) {
    asm volatile("s_waitcnt vmcnt(0)" ::: "memory");
    __syncthreads();
    if (threadIdx.x == 0) {
        unsigned* bar = b.bar;
        __builtin_amdgcn_s_waitcnt(0);
        unsigned nloc = b.st[0], nx = b.st[1];
        if (nloc == 0u) { xcd_barrier_complete(bar, b.x, nloc, nx); b.st[0] = nloc; b.st[1] = nx; }
        const unsigned old = xb_add(&bar[XB_XSUB(b.x)], 1u);
        const unsigned gen = old / nloc;
        if (old + 1u == (gen + 1u) * nloc) {
            __builtin_amdgcn_fence(__ATOMIC_RELEASE, "agent");
            asm volatile("s_waitcnt vmcnt(0)" ::: "memory");
            const unsigned og = xb_add(&bar[XB_TOP], 1u);
            const unsigned tg = og / nx;
            if (og + 1u == (tg + 1u) * nx) xb_add(&bar[XB_TOPGEN], 1u);
            else XB_SPIN(xb_ld(&bar[XB_TOPGEN]) == tg, bar);
            __builtin_amdgcn_fence(__ATOMIC_ACQUIRE, "agent");
            xb_add(&bar[XB_XGEN(b.x)], 1u);
            asm volatile("s_waitcnt vmcnt(0)" ::: "memory");
        } else {
            XB_SPIN(xb_ld(&bar[XB_XGEN(b.x)]) == gen, bar);
            __builtin_amdgcn_fence(__ATOMIC_ACQUIRE, "agent");
            asm volatile("s_waitcnt vmcnt(0)" ::: "memory");
        }
    }
    __syncthreads();
}

constexpr int NWAVES = 8, NTHR = 512;
constexpr int RING_BYTES = 131072, XTRA_OFF = RING_BYTES, LDSCTL_OFF = 163840 - 256, LDS_BYTES = 163840;
constexpr int CW_BAR = 4096, CW_PANEL = 12288;
constexpr int NPH = 8;
constexpr int NAT_REP = 1;
constexpr int FFT_REP = 1;
constexpr int KREP_[NPH] = {1, 1, 1, 1, 1, 1, 1, 1};

struct Params { const float *xp, *xs, *g_mix, *w_in, *q_norm, *k_norm, *rpb, *w_fo, *w_ao, *w_out, *g_mlp, *w1, *w2; float* out; unsigned char* ws; int ph_lo, ph_hi, li, pad; };

__device__ __forceinline__ float xsum16(float v) { const auto r = __builtin_amdgcn_permlane16_swap(__float_as_uint(v), __float_as_uint(v), false, false); return __uint_as_float(r[0]) + __uint_as_float(r[1]); }
__device__ __forceinline__ float xsum32(float v) { const auto r = __builtin_amdgcn_permlane32_swap(__float_as_uint(v), __float_as_uint(v), false, false); return __uint_as_float(r[0]) + __uint_as_float(r[1]); }
__device__ __forceinline__ float xmax16(float v) { const auto r = __builtin_amdgcn_permlane16_swap(__float_as_uint(v), __float_as_uint(v), false, false); return fmaxf(__uint_as_float(r[0]), __uint_as_float(r[1])); }
__device__ __forceinline__ float xmax32(float v) { const auto r = __builtin_amdgcn_permlane32_swap(__float_as_uint(v), __float_as_uint(v), false, false); return fmaxf(__uint_as_float(r[0]), __uint_as_float(r[1])); }
__device__ __forceinline__ float wave_sum(float v) {
#pragma unroll
    for (int o = 1; o < 64; o <<= 1) v += __shfl_xor(v, o);
    return v;
}
#define LDS_WAIT() asm volatile("s_waitcnt lgkmcnt(0)" ::: "memory")

struct WItem { const float* src; const float* gain; bf16_t* dst; int N, ldo; float sc; };
__device__ __forceinline__ bool p0_resolve(const Params& p, int it, WItem& w) {
    unsigned char* ws = p.ws;
    constexpr int I_IN = (D / 64) * (INW / 32), I_FO = (FW / 64) * (D / 32), I_AO = I_FO, I_OUT = (D / 64) * (D / 32), I_1 = (D / 64) * (DFF / 32), I_2 = (DFF / 64) * (D / 32);
    int r = it; const float* W; const float* g; bf16_t* WT; int N, ldo, co;
    if (r < I_IN) { W = p.w_in; g = p.g_mix; WT = (bf16_t*)(ws + WS_WIN); N = INW; ldo = D; co = 0; }
    else if ((r -= I_IN) < I_FO) { W = p.w_fo; g = nullptr; WT = (bf16_t*)(ws + WS_WFO); N = D; ldo = FW; co = 0; }
    else if ((r -= I_FO) < I_AO) { W = p.w_ao; g = nullptr; WT = (bf16_t*)(ws + WS_WAO); N = D; ldo = AW; co = 0; }
    else if ((r -= I_AO) < I_OUT) { W = p.w_out; g = nullptr; WT = (bf16_t*)(ws + WS_WOUT); N = D; ldo = D; co = 0; }
    else if ((r -= I_OUT) < I_1) { W = p.w1; g = p.g_mlp; WT = (bf16_t*)(ws + WS_W1); N = DFF; ldo = D; co = 0; }
    else if ((r -= I_1) < I_2) { W = p.w2; g = nullptr; WT = (bf16_t*)(ws + WS_W2); N = D; ldo = DFF; co = 0; }
    else return false;
    const int nblk = N / 32, kb = r / nblk, nb = r % nblk, k0 = 64 * kb, n0 = 32 * nb;
    w.src = W + (size_t)k0 * N + n0; w.gain = g ? g + k0 : nullptr; w.dst = WT + (size_t)n0 * ldo + co + k0; w.N = N; w.ldo = ldo; w.sc = (W == p.w_in && n0 >= 4096) ? -LOG2E : 1.f;
    return true;
}
__device__ __forceinline__ void p0_load(const WItem& w, f32x4 (&v)[8], float (&g)[8], int lane) {
#pragma unroll
    for (int j = 0; j < 8; ++j) { const int kk = (lane >> 3) + 8 * j; v[j] = *(const f32x4*)(w.src + (size_t)kk * w.N + (lane & 7) * 4); g[j] = (w.gain ? w.gain[kk] : 1.f) * w.sc; }
}
__device__ __forceinline__ void p0_process(const WItem& w, const f32x4 (&v)[8], const float (&g)[8], LAS float* scr, int lane) {
#pragma unroll
    for (int j = 0; j < 8; ++j) { const int kk = (lane >> 3) + 8 * j; LAS float* d = scr + kk * 33 + (lane & 7) * 4; const f32x4 x = v[j] * g[j]; d[0] = x[0]; d[1] = x[1]; d[2] = x[2]; d[3] = x[3]; }
    LDS_WAIT(); asm volatile("" ::: "memory");
    const int c = lane & 7;
#pragma unroll
    for (int j = 0; j < 4; ++j) { const int n = (lane >> 3) + 8 * j; const LAS float* s = scr + (8 * c) * 33 + n;
        u32x4 o; o.x = g8::cvt_pk_bf16(s[0 * 33], s[1 * 33]); o.y = g8::cvt_pk_bf16(s[2 * 33], s[3 * 33]); o.z = g8::cvt_pk_bf16(s[4 * 33], s[5 * 33]); o.w = g8::cvt_pk_bf16(s[6 * 33], s[7 * 33]);
        *(u32x4*)(w.dst + (size_t)n * w.ldo + 8 * c) = o; }
    LDS_WAIT(); asm volatile("" ::: "memory");
}
__device__ __forceinline__ void p0_xrow(const f32x4 (&v)[8], float* rstd1, bf16_t* XB, int m, int lane) {
    float s = 0.f;
#pragma unroll
    for (int j = 0; j < 8; ++j) s += (v[j].x * v[j].x + v[j].y * v[j].y) + (v[j].z * v[j].z + v[j].w * v[j].w);
    s = wave_sum(s);
    const float rs = rsqrtf(s * (1.f / D) + EPS);
    u32x4* o16 = (u32x4*)(XB + (size_t)m * D) + lane;
#pragma unroll
    for (int j = 0; j < 4; ++j) { u32x4 w; w.x = g8::cvt_pk_bf16(v[2 * j].x * rs, v[2 * j].y * rs); w.y = g8::cvt_pk_bf16(v[2 * j].z * rs, v[2 * j].w * rs);
        w.z = g8::cvt_pk_bf16(v[2 * j + 1].x * rs, v[2 * j + 1].y * rs); w.w = g8::cvt_pk_bf16(v[2 * j + 1].z * rs, v[2 * j + 1].w * rs); o16[64 * j] = w; }
}
__device__ __forceinline__ void p0_prologue(const Params& p, LAS unsigned char* lds, int gw, int NGW, int lane, int wave) {
    unsigned char* ws = p.ws;
    LAS float* scr = (LAS float*)(lds + wave * 16384);
    {
        WItem wa, wb; f32x4 va[8], vb[8]; float ga[8], gb[8];
        int it = gw; bool ha = p0_resolve(p, it, wa); if (ha) p0_load(wa, va, ga, lane);
        while (ha) {
            const bool hb = p0_resolve(p, it + NGW, wb); if (hb) p0_load(wb, vb, gb, lane);
            p0_process(wa, va, ga, scr, lane);
            if (!hb) break;
            it += 2 * NGW; ha = p0_resolve(p, it, wa); if (ha) p0_load(wa, va, ga, lane);
            p0_process(wb, vb, gb, scr, lane);
        }
    }
    XIn x{p.xp, p.xs}; float* rstd1 = (float*)(ws + T_RSTD1); bf16_t* XB = (bf16_t*)(ws + WS_XB);
    {
        f32x4 va[8], vb[8]; int m = gw;
        if (m < M) {
#pragma unroll
            for (int j = 0; j < 8; ++j) va[j] = ((const f32x4*)x.row(m) + 2 * lane + (j & 1))[128 * (j >> 1)]; }
        while (m < M) {
            const int m2 = m + NGW;
            if (m2 < M) {
#pragma unroll
                for (int j = 0; j < 8; ++j) vb[j] = ((const f32x4*)x.row(m2) + 2 * lane + (j & 1))[128 * (j >> 1)]; }
            p0_xrow(va, rstd1, XB, m, lane);
            if (m2 >= M) break;
            m = m2 + NGW;
            if (m < M) {
#pragma unroll
                for (int j = 0; j < 8; ++j) va[j] = ((const f32x4*)x.row(m) + 2 * lane + (j & 1))[128 * (j >> 1)]; }
            p0_xrow(vb, rstd1, XB, m2, lane);
        }
    }
    bf16_t* Tc = (bf16_t*)(ws + T_DFTC); bf16_t* Ts = (bf16_t*)(ws + T_DFTS);
    for (int i = gw * 64 + lane; i < 65536; i += NGW * 64) { const int a = ((i >> 8) * (i & 255)) & 255; const float ang = (float)a * (1.f / 128.f);
        Tc[i] = f2bf(cospif(ang) * S_ORTHO); Ts[i] = f2bf(sinpif(ang) * S_ORTHO); }
    { bf16_t* Tcs = (bf16_t*)(ws + T_CS);
      for (int i = gw * 64 + lane; i < 2 * 256 * 512; i += NGW * 64) { const int k = i & 511, n = (i >> 9) & 255, hh = i >> 17, cp = 128 * hh + (n & 127), a = (cp * (k & 255)) & 255; const float ang = (float)a * (1.f / 128.f);
          Tcs[i] = f2bf(k < 256 ? cospif(ang) * S_ORTHO : (n < 128 ? sinpif(ang) : -sinpif(ang)) * S_ORTHO); } }
    bf16_t* F128C = (bf16_t*)(ws + T_F128C); bf16_t* F128S = (bf16_t*)(ws + T_F128S); bf16_t* F64T = (bf16_t*)(ws + T_F64);
    for (int i = gw * 64 + lane; i < 16384; i += NGW * 64) { const int a = ((i >> 7) * (i & 127)) & 127; const float ang = (float)a * (1.f / 64.f);
        F128C[i] = f2bf(cospif(ang)); F128S[i] = f2bf(-sinpif(ang)); }
    for (int i = gw * 64 + lane; i < 3 * 64 * 72; i += NGW * 64) { const int tb = i / (64 * 72), k2 = (i / 72) % 64, sl = i % 72; float v = 0.f;
        if (sl < 64) { const int q4 = sl >> 4, hh = (sl >> 3) & 1, e = sl & 7, n2 = 16 * q4 + 8 * (e >> 2) + 4 * hh + (e & 3); const float ang = (float)((k2 * n2) & 63) * (1.f / 32.f);
            v = tb == 0 ? cospif(ang) : (tb == 1 ? sinpif(ang) : -sinpif(ang)); }
        F64T[i] = f2bf(v); }
    float* rp = (float*)(ws + T_RPB);
    for (int i = gw * 64 + lane; i < NH * 15 * 31; i += NGW * 64) rp[i] = p.rpb[i] * LOG2E;
}

template <int nM, int nN, int nt, int lda, int ldb> struct SchedGrid {
    static constexpr bool HAS_KEEP = false;
    const char* A; const char* B; int G, c;
    __device__ __forceinline__ bool next(int i, g8::Unit& u) const {
        const int L = i * G + c; if (L >= nM * nN) return false;
        int pm, pn; g8::tile_of<(nN <= 8 ? 8 : 4)>(L, nM, nN, pm, pn);
        u.pm = pm; u.pn = pn; u.nt = nt; u.keep = 0; u.br = 0;
        u.a = A + (size_t)pm * 256 * lda * 2; u.b = B + (size_t)pn * 256 * ldb * 2; return true;
    }
};
struct EpiChDft {
    bf16_t* Y;
    __device__ __forceinline__ void operator()(f32x4 (&acc)[2][2][4][2], const g8::Unit& u, int wr, int wc, int fr, int fq) const {
        if (u.keep) return;
        asm volatile("" : "+v"(fr), "+v"(fq));
        const int k0 = (u.pm & 15) * 256 + wr * 64 + fr;
        bf16_t* const Yb = Y + (size_t)(u.pm >> 4) * SEQ * FW + (u.pn * 128 + 32 * wc + 8 * fq);
#pragma unroll
        for (int ai = 0; ai < 2; ++ai)
#pragma unroll
            for (int m = 0; m < 4; ++m) { const int k = k0 + ai * 128 + m * 16;
#pragma unroll
                for (int bj = 0; bj < 2; ++bj) { const f32x4 v0 = acc[ai][bj][m][0], v1 = acc[ai][bj][m][1];
                    u32x4 w; w.x = g8::cvt_pk_bf16(v0[0], v0[1]); w.y = g8::cvt_pk_bf16(v0[2], v0[3]); w.z = g8::cvt_pk_bf16(v1[0], v1[1]); w.w = g8::cvt_pk_bf16(v1[2], v1[3]);
                    *(u32x4*)(Yb + (size_t)(bj ? ((SEQ - k) & (SEQ - 1)) : k) * FW) = w; } }
    }
};
struct EpiP1 {
    unsigned char* ws; bf16_t* gates; LAS unsigned char* xtra;
    __device__ __forceinline__ void operator()(f32x4 (&acc)[2][2][4][2], const g8::Unit& u, int wr, int wc, int fr, int fq) const {
        asm volatile("" : "+v"(fr), "+v"(fq));
        bf16_t* const Q = (bf16_t*)(ws + WS_Q); bf16_t* const Kb = (bf16_t*)(ws + WS_K); bf16_t* const V = (bf16_t*)(ws + WS_V); bf16_t* const FT = (bf16_t*)(ws + WS_FT); bf16_t* const SA = gates; bf16_t* const SB = gates + (size_t)M * D;
        const int pn = u.pn, row0 = u.pm * 256 + wr * 64 + fr;
        float rs[2][4];
#pragma unroll
        for (int ai = 0; ai < 2; ++ai)
#pragma unroll
            for (int m = 0; m < 4; ++m) rs[ai][m] = 1.f;
        if (pn < 8) {
            const bool isq = pn < 4; const LAS float* gn = (const LAS float*)(xtra + 16384) + (isq ? 0 : 64); bf16_t* O = isq ? Q : Kb; const int head = (pn & 3) * 4 + wc;
            f32x4 gv[2][2];
#pragma unroll
            for (int bj = 0; bj < 2; ++bj)
#pragma unroll
                for (int n = 0; n < 2; ++n) gv[bj][n] = *(const LAS f32x4*)(gn + 32 * bj + 8 * fq + 4 * n);
#pragma unroll
            for (int ai = 0; ai < 2; ++ai)
#pragma unroll
                for (int m = 0; m < 4; ++m) { const int r = row0 + ai * 128 + m * 16; const float rsv = rs[ai][m]; float ss = 0.f;
#pragma unroll
                    for (int bj = 0; bj < 2; ++bj)
#pragma unroll
                        for (int n = 0; n < 2; ++n) { const f32x4 v = acc[ai][bj][m][n]; ss += (v[0] * v[0] + v[1] * v[1]) + (v[2] * v[2] + v[3] * v[3]); }
                    ss = xsum32(xsum16(ss));
                    const float rn = rsqrtf(ss * rsv * rsv * (1.f / 64.f) + EPS) * rsv * (isq ? QSCALE : 1.f);
#pragma unroll
                    for (int bj = 0; bj < 2; ++bj) { const f32x4 v0 = acc[ai][bj][m][0] * rn * gv[bj][0], v1 = acc[ai][bj][m][1] * rn * gv[bj][1];
                        u32x4 w; w.x = g8::cvt_pk_bf16(v0[0], v0[1]); w.y = g8::cvt_pk_bf16(v0[2], v0[3]); w.z = g8::cvt_pk_bf16(v1[0], v1[1]); w.w = g8::cvt_pk_bf16(v1[2], v1[3]);
                        *(u32x4*)(O + (size_t)r * AW + head * 64 + 32 * bj + 8 * fq) = w; } }
        } else if (pn >= 12 && pn < 16) {
            const int b = (u.pm * 256) / SEQ; bf16_t* Fb = FT + ((size_t)b * FW + (pn - 12) * 256 + wr * 64 + fr) * SEQ + (u.pm * 256 - b * SEQ);
#pragma unroll
            for (int ai = 0; ai < 2; ++ai)
#pragma unroll
                for (int m = 0; m < 4; ++m) { bf16_t* rowp = Fb + (size_t)(ai * 128 + m * 16) * SEQ;
#pragma unroll
                    for (int bj = 0; bj < 2; ++bj) { const f32x4 v0 = acc[ai][bj][m][0], v1 = acc[ai][bj][m][1];
                        u32x4 w; w.x = g8::cvt_pk_bf16(v0[0], v0[1]); w.y = g8::cvt_pk_bf16(v0[2], v0[3]); w.z = g8::cvt_pk_bf16(v1[0], v1[1]); w.w = g8::cvt_pk_bf16(v1[2], v1[3]);
                        *(u32x4*)(rowp + g8::colbase<true>(bj, wc, fq)) = w; } }
        } else if (pn < 12) { store_rows<false>(acc, rs, V, AW, (pn - 8) * 256, row0, wc, fq);
        } else { store_rows<true>(acc, rs, pn < 24 ? SA : SB, D, ((pn - 16) & 7) * 256, row0, wc, fq); }
    }
    template <bool SIG> __device__ __forceinline__ void store_rows(const f32x4 (&acc)[2][2][4][2], const float (&rs)[2][4], bf16_t* O, int ldo, int cb, int row0, int wc, int fq) const {
#pragma unroll
        for (int ai = 0; ai < 2; ++ai)
#pragma unroll
            for (int m = 0; m < 4; ++m) { const int r = row0 + ai * 128 + m * 16; const float rsv = rs[ai][m];
#pragma unroll
                for (int bj = 0; bj < 2; ++bj) { f32x4 v0 = acc[ai][bj][m][0] * rsv, v1 = acc[ai][bj][m][1] * rsv;
                    if (SIG) {
#pragma unroll
                        for (int e = 0; e < 4; ++e) { v0[e] = __builtin_amdgcn_rcpf(1.f + __builtin_amdgcn_exp2f(v0[e])); v1[e] = __builtin_amdgcn_rcpf(1.f + __builtin_amdgcn_exp2f(v1[e])); } }
                    u32x4 w; w.x = g8::cvt_pk_bf16(v0[0], v0[1]); w.y = g8::cvt_pk_bf16(v0[2], v0[3]); w.z = g8::cvt_pk_bf16(v1[0], v1[1]); w.w = g8::cvt_pk_bf16(v1[2], v1[3]);
                    *(u32x4*)(O + (size_t)r * ldo + cb + g8::colbase<true>(bj, wc, fq)) = w; }
                __builtin_amdgcn_sched_barrier(0); }
    }
};

struct SchedP1 {
    static constexpr bool HAS_KEEP = false;
    const char* XB; const char* W; int G, c;
    __device__ __forceinline__ bool next(int i, g8::Unit& u) const {
        const int L = i * G + c; if (L >= (M / 256) * (INW / 256)) return false;
        int pm, pn; g8::tile_of<4>(L, M / 256, INW / 256, pm, pn);
        u.pm = pm; u.pn = pn; u.nt = D / 64; u.keep = 0; u.br = 0;
        const char* xa = XB + (size_t)pm * 256 * D * 2; const char* wb = W + (size_t)pn * 256 * D * 2; const bool sw = pn >= 12 && pn < 16;
        u.a = sw ? wb : xa; u.b = sw ? xa : wb; return true;
    }
};
struct SchedChDft {
    static constexpr bool HAS_KEEP = true;
    const char* PT; const char* TCS; int G, c;
    __device__ __forceinline__ bool next(int i, g8::Unit& u) const {
        const int L = (i >> 1) * G + c; if (L >= 48 * 8) return false;
        int pm, pn; g8::tile_of<8>(L, 48, 8, pm, pn); const int seg = i & 1, g = pn >> 1, h = pn & 1;
        u.pm = pm; u.pn = pn; u.nt = 4; u.keep = seg == 0; u.br = 0;
        u.a = PT + ((size_t)((pm >> 4) * 2 + seg) * FW + g * 256) * SEQ * 2 + (size_t)(pm & 15) * 256 * 2; u.b = TCS + (size_t)h * 256 * 512 * 2 + seg * 256 * 2; return true;
    }
};
struct SchedMerge2 {
    static constexpr bool HAS_KEEP = false;
    const char* Y; const char* ATT; const char* WFO; const char* WAO; int G, c;
    __device__ __forceinline__ bool next(int i, g8::Unit& u) const {
        const int L = (i >> 1) * G + c; if (L >= 96 * 8) return false;
        int pm, pn; g8::tile_of<8>(L, 96, 8, pm, pn); const int br = i & 1;
        u.pm = pm; u.pn = pn; u.nt = 16; u.keep = 0; u.br = br;
        u.a = (br ? ATT : Y) + (size_t)pm * 256 * 1024 * 2; u.b = (br ? WAO : WFO) + (size_t)pn * 256 * 1024 * 2; return true;
    }
};
__device__ __forceinline__ f32x4 bf_lo4(const u32x4 w, int half) { return half == 0 ? (f32x4){__uint_as_float(w[0] << 16), __uint_as_float(w[0] & 0xffff0000u), __uint_as_float(w[1] << 16), __uint_as_float(w[1] & 0xffff0000u)}
                                                                                       : (f32x4){__uint_as_float(w[2] << 16), __uint_as_float(w[2] & 0xffff0000u), __uint_as_float(w[3] << 16), __uint_as_float(w[3] & 0xffff0000u)}; }
__device__ __forceinline__ u32x4 pack8(const f32x4 v0, const f32x4 v1) { u32x4 w; w.x = g8::cvt_pk_bf16(v0[0], v0[1]); w.y = g8::cvt_pk_bf16(v0[2], v0[3]); w.z = g8::cvt_pk_bf16(v1[0], v1[1]); w.w = g8::cvt_pk_bf16(v1[2], v1[3]); return w; }
struct EpiMerge {
    unsigned char* ws; const bf16_t* gates;
    template <bool SECOND> __device__ __forceinline__ void run(f32x4 (&acc)[2][2][4][2], const g8::Unit& u, int wr, int wc, int fr, int fq) const {
        asm volatile("" : "+v"(fr), "+v"(fq));
        bf16_t* const MG = (bf16_t*)(ws + WS_MERGED); const bf16_t* const SA = gates; const bf16_t* const SB = gates + (size_t)M * D;
        const char* S = (const char*)(SECOND ? SB : SA); char* const MGb = (char*)MG;
        unsigned o0 = ((unsigned)(u.pm * 256 + wr * 64 + fr) * D + u.pn * 256 + g8::colbase<false>(0, wc, fq)) * 2u;
#define MRG_LD(d_, off_, base_) asm volatile("global_load_dwordx4 %0, %1, %2" : "=v"(d_) : "v"(off_), "s"(base_) : "memory")
#define MRG_OFF(ai_, m_, bj_) (o0 + (unsigned)((((ai_) * 128 + (m_) * 16) * D + (bj_) * 128) * 2))
        u32x4 ow[2][4][2];
        if constexpr (!SECOND) {
            u32x4 sg[2][4][2];
#pragma unroll
            for (int ai = 0; ai < 2; ++ai)
#pragma unroll
                for (int m = 0; m < 4; ++m)
#pragma unroll
                    for (int bj = 0; bj < 2; ++bj) { const unsigned o = MRG_OFF(ai, m, bj); MRG_LD(sg[ai][m][bj], o, S); }
#define MRG_ST0(ai_, m_, W_) do { asm volatile(W_ : "+v"(sg[ai_][m_][0]), "+v"(sg[ai_][m_][1]) :: "memory"); \
                _Pragma("unroll") for (int bj = 0; bj < 2; ++bj) ow[ai_][m_][bj] = pack8(bf_lo4(sg[ai_][m_][bj], 0) * acc[ai_][bj][m_][0], bf_lo4(sg[ai_][m_][bj], 1) * acc[ai_][bj][m_][1]); __builtin_amdgcn_sched_barrier(0); } while (0)
            MRG_ST0(0, 0, "s_waitcnt vmcnt(14)"); MRG_ST0(0, 1, "s_waitcnt vmcnt(12)"); MRG_ST0(0, 2, "s_waitcnt vmcnt(10)"); MRG_ST0(0, 3, "s_waitcnt vmcnt(8)");
            MRG_ST0(1, 0, "s_waitcnt vmcnt(6)"); MRG_ST0(1, 1, "s_waitcnt vmcnt(4)"); MRG_ST0(1, 2, "s_waitcnt vmcnt(2)"); MRG_ST0(1, 3, "s_waitcnt vmcnt(0)");
#undef MRG_ST0
        } else {
#pragma unroll
            for (int ai = 0; ai < 2; ++ai) {
                u32x4 sg[4][2], pv[4][2];
#pragma unroll
                for (int m = 0; m < 4; ++m)
#pragma unroll
                    for (int bj = 0; bj < 2; ++bj) { const unsigned o = MRG_OFF(ai, m, bj); MRG_LD(sg[m][bj], o, S); MRG_LD(pv[m][bj], o, MGb); }
#define MRG_ST1(m_, W_) do { asm volatile(W_ : "+v"(sg[m_][0]), "+v"(sg[m_][1]), "+v"(pv[m_][0]), "+v"(pv[m_][1]) :: "memory"); \
                _Pragma("unroll") for (int bj = 0; bj < 2; ++bj) ow[ai][m_][bj] = pack8(bf_lo4(sg[m_][bj], 0) * acc[ai][bj][m_][0] + bf_lo4(pv[m_][bj], 0), bf_lo4(sg[m_][bj], 1) * acc[ai][bj][m_][1] + bf_lo4(pv[m_][bj], 1)); __builtin_amdgcn_sched_barrier(0); } while (0)
                MRG_ST1(0, "s_waitcnt vmcnt(12)"); MRG_ST1(1, "s_waitcnt vmcnt(8)"); MRG_ST1(2, "s_waitcnt vmcnt(4)"); MRG_ST1(3, "s_waitcnt vmcnt(0)");
#undef MRG_ST1
            }
        }
#undef MRG_LD
#undef MRG_OFF
#pragma unroll
        for (int ai = 0; ai < 2; ++ai)
#pragma unroll
            for (int m = 0; m < 4; ++m)
#pragma unroll
                for (int bj = 0; bj < 2; ++bj) *(u32x4*)(MGb + (o0 + (unsigned)(((ai * 128 + m * 16) * D + bj * 128) * 2))) = ow[ai][m][bj];
    }
};
struct EpiMergeBr { EpiMerge e;
    __device__ __forceinline__ void operator()(f32x4 (&acc)[2][2][4][2], const g8::Unit& u, int wr, int wc, int fr, int fq) const { if (u.br) e.template run<true>(acc, u, wr, wc, fr, fq); else e.template run<false>(acc, u, wr, wc, fr, fq); } };
struct EpiX1 {
    XIn x; unsigned char* ws;
    __device__ __forceinline__ void operator()(f32x4 (&acc)[2][2][4][2], const g8::Unit& u, int wr, int wc, int fr, int fq) const {
        asm volatile("" : "+v"(fr), "+v"(fq));
        bf16_t* const X1B = (bf16_t*)(ws + WS_X1B); float* const SSQ = (float*)(ws + WS_SSQ);
        const int row0 = u.pm * 256 + wr * 64 + fr; const char* xbase = (const char*)((u.pm < SEQ / 256) ? x.xp : x.xs - (size_t)SEQ * D);
        const unsigned e0 = (unsigned)row0 * D + u.pn * 256 + g8::colbase<false>(0, wc, fq);
        u32x4 ow[2][4][2]; float ssr[2][4]; unsigned tok = 0;
#pragma unroll
        for (int ai = 0; ai < 2; ++ai) {
#pragma unroll
            for (int m = 0; m < 4; ++m) { const unsigned er = e0 + tok + (unsigned)((ai * 128 + m * 16) * D); float ss = 0.f;
#pragma unroll
                for (int bj = 0; bj < 2; ++bj) { const char* xr = xbase + (er + bj * 128) * 4u;
                    const f32x4 v0 = acc[ai][bj][m][0] + *(const f32x4*)xr, v1 = acc[ai][bj][m][1] + *(const f32x4*)(xr + 16);
                    ss += (v0[0] * v0[0] + v0[1] * v0[1]) + (v0[2] * v0[2] + v0[3] * v0[3]) + (v1[0] * v1[0] + v1[1] * v1[1]) + (v1[2] * v1[2] + v1[3] * v1[3]);
                    ow[ai][m][bj] = pack8(v0, v1); }
                if (m == 3) asm volatile("" : "+v"(tok), "+v"(ss));
                ssr[ai][m] = ss; } }
        asm volatile("" ::: "memory");
#pragma unroll
        for (int ai = 0; ai < 2; ++ai)
#pragma unroll
            for (int m = 0; m < 4; ++m) { const int r = row0 + ai * 128 + m * 16;
#pragma unroll
                for (int bj = 0; bj < 2; ++bj) *(u32x4*)((char*)X1B + (e0 + (unsigned)((ai * 128 + m * 16) * D + bj * 128)) * 2u) = ow[ai][m][bj];
                float ss = ssr[ai][m]; ss = xsum32(xsum16(ss));
                if (fq == 0) *(float*)((char*)SSQ + ((unsigned)r * 32u + u.pn * 4 + wc) * 4u) = ss; }
    }
};
__device__ __forceinline__ size_t tmp_base(int pm) { return pm < 48 ? WS_TMP0 : (WS_TMP1 - (size_t)48 * MiB); }
struct EpiTmp {
    unsigned char* ws;
    __device__ __forceinline__ void operator()(f32x4 (&acc)[2][2][4][2], const g8::Unit& u, int wr, int wc, int fr, int fq) const {
        asm volatile("" : "+v"(fr), "+v"(fq));
        const int row0 = u.pm * 256 + wr * 64 + fr; bf16_t* T = (bf16_t*)(ws + tmp_base(u.pm));
#pragma unroll
        for (int ai = 0; ai < 2; ++ai)
#pragma unroll
            for (int m = 0; m < 4; ++m) { bf16_t* rowp = T + (size_t)(row0 + ai * 128 + m * 16) * D + (u.pn * 256);
#pragma unroll
                for (int bj = 0; bj < 2; ++bj) { const f32x4 v0 = acc[ai][bj][m][0], v1 = acc[ai][bj][m][1];
                    u32x4 w; w.x = g8::cvt_pk_bf16(v0[0], v0[1]); w.y = g8::cvt_pk_bf16(v0[2], v0[3]); w.z = g8::cvt_pk_bf16(v1[0], v1[1]); w.w = g8::cvt_pk_bf16(v1[2], v1[3]);
                    *(u32x4*)(rowp + g8::colbase<false>(bj, wc, fq)) = w; } }
    }
};
struct EpiOut {
    float* out; const unsigned char* ws;
    __device__ __forceinline__ void operator()(f32x4 (&acc)[2][2][4][2], const g8::Unit& u, int wr, int wc, int fr, int fq) const {
        asm volatile("" : "+v"(fr), "+v"(fq));
        const bf16_t* const X1B = (const bf16_t*)(ws + WS_X1B); const float* const r2 = (const float*)(ws + T_RSTD2);
        const int row0 = u.pm * 256 + wr * 64 + fr; const bf16_t* T = (const bf16_t*)(ws + tmp_base(u.pm));
#pragma unroll
        for (int ai = 0; ai < 2; ++ai) {
#pragma unroll
            for (int m = 0; m < 4; ++m) { const int r = row0 + ai * 128 + m * 16; const float sc = r2[r]; const size_t ro = (size_t)r * D + (u.pn * 256);
#pragma unroll
                for (int bj = 0; bj < 2; ++bj) { const size_t o = ro + g8::colbase<false>(bj, wc, fq);
                    const u32x4 tv = *(const u32x4*)(T + o), xv = *(const u32x4*)(X1B + o);
                    const f32x4 r0 = bf_lo4(xv, 0) + (bf_lo4(tv, 0) + acc[ai][bj][m][0]) * sc, r1 = bf_lo4(xv, 1) + (bf_lo4(tv, 1) + acc[ai][bj][m][1]) * sc;
                    acc[ai][bj][m][0] = r0; acc[ai][bj][m][1] = r1; } }
            asm volatile("" ::: "memory"); }
#pragma unroll
        for (int ai = 0; ai < 2; ++ai)
#pragma unroll
            for (int m = 0; m < 4; ++m) { float* rowp = out + (size_t)(row0 + ai * 128 + m * 16) * D + (u.pn * 256);
#pragma unroll
                for (int bj = 0; bj < 2; ++bj) { const int cb = g8::colbase<false>(bj, wc, fq);
                    *(f32x4*)(rowp + cb) = acc[ai][bj][m][0]; *(f32x4*)(rowp + cb + 4) = acc[ai][bj][m][1]; } }
    }
};
__device__ __forceinline__ float relu_i(float x) { const int i = __builtin_bit_cast(int, x); return __builtin_bit_cast(float, i > 0 ? i : 0); }
struct EpiRelu2 {
    bf16_t* Ua; bf16_t* Ub;
    __device__ __forceinline__ void operator()(f32x4 (&acc)[2][2][4][2], const g8::Unit& u, int wr, int wc, int fr, int fq) const {
        asm volatile("" : "+v"(fr), "+v"(fq));
        const int row0 = u.pm * 256 + wr * 64 + fr; bf16_t* const U = (u.pn < 16) ? Ua : Ub; const int cb0 = (u.pn & 15) * 256;
#pragma unroll
        for (int ai = 0; ai < 2; ++ai)
#pragma unroll
            for (int m = 0; m < 4; ++m) { bf16_t* rowp = U + (size_t)(row0 + ai * 128 + m * 16) * 4096 + cb0;
#pragma unroll
                for (int bj = 0; bj < 2; ++bj) { f32x4 v0 = acc[ai][bj][m][0], v1 = acc[ai][bj][m][1];
#pragma unroll
                    for (int e = 0; e < 4; ++e) { const float a = relu_i(v0[e]), b = relu_i(v1[e]); v0[e] = a * a; v1[e] = b * b; }
                    u32x4 w; w.x = g8::cvt_pk_bf16(v0[0], v0[1]); w.y = g8::cvt_pk_bf16(v0[2], v0[3]); w.z = g8::cvt_pk_bf16(v1[0], v1[1]); w.w = g8::cvt_pk_bf16(v1[2], v1[3]);
                    *(u32x4*)(rowp + g8::colbase<false>(bj, wc, fq)) = w; } }
    }
};
struct SchedDown {
    static constexpr bool HAS_KEEP = true;
    const char* Ua; const char* Ub; const char* W2; int G, c;
    __device__ __forceinline__ bool next(int i, g8::Unit& u) const {
        const int L = (i >> 1) * G + c; if (L >= 96 * 8) return false;
        int pm, pn; g8::tile_of<4>(L, 96, 8, pm, pn); const int seg = i & 1;
        u.pm = pm; u.pn = pn; u.nt = 64; u.keep = seg == 0; u.br = 0;
        u.a = (seg ? Ua : Ub) + (size_t)pm * 256 * 4096 * 2; u.b = W2 + ((size_t)pn * 256 * DFF + (seg ? 0 : 4096)) * 2; return true;
    }
};
struct EpiDown {
    float* out; const unsigned char* ws; unsigned* pcnt;
    __device__ __forceinline__ void operator()(f32x4 (&acc)[2][2][4][2], const g8::Unit& u, int wr, int wc, int fr, int fq) const {
        const bool t0 = (wr == 0) && (wc == 0) && (fr == 0) && (fq == 0);
        unsigned* cnt = pcnt + 16 * u.pm;
        if (u.keep) {
            if (t0) __hip_atomic_fetch_add(cnt, 1u, __ATOMIC_RELAXED, __HIP_MEMORY_SCOPE_AGENT);
            return; }
        if (t0) { unsigned sp = 0; while (__hip_atomic_load(cnt, __ATOMIC_RELAXED, __HIP_MEMORY_SCOPE_AGENT) < 8u && ++sp < (1u << 16)) __builtin_amdgcn_s_sleep(2); }
        __builtin_amdgcn_s_barrier();
        asm volatile("" : "+v"(fr), "+v"(fq));
        const bf16_t* const X1B = (const bf16_t*)(ws + WS_X1B); const float* const r2 = (const float*)(ws + T_RSTD2);
        const int row0 = u.pm * 256 + wr * 64 + fr;
        const unsigned e0 = (unsigned)row0 * D + u.pn * 256 + g8::colbase<false>(0, wc, fq);
#pragma unroll
        for (int ai = 0; ai < 2; ++ai) {
            u32x4 xv[4][2]; float scv[4];
#pragma unroll
            for (int m = 0; m < 4; ++m) { const float sc = *(const float*)((const char*)r2 + (unsigned)(row0 + ai * 128 + m * 16) * 4u);
#pragma unroll
                for (int bj = 0; bj < 2; ++bj) xv[m][bj] = *(const u32x4*)((const char*)X1B + (e0 + (unsigned)((ai * 128 + m * 16) * D + bj * 128)) * 2u);
                scv[m] = sc; }
            asm volatile("" : "+v"(xv[0][0]), "+v"(xv[0][1]), "+v"(xv[1][0]), "+v"(xv[1][1]), "+v"(xv[2][0]), "+v"(xv[2][1]), "+v"(xv[3][0]), "+v"(xv[3][1]));
#pragma unroll
            for (int m = 0; m < 4; ++m) {
#pragma unroll
                for (int bj = 0; bj < 2; ++bj) { char* op = (char*)out + (e0 + (unsigned)((ai * 128 + m * 16) * D + bj * 128)) * 4u;
                    const f32x4 r0 = bf_lo4(xv[m][bj], 0) + acc[ai][bj][m][0] * scv[m], r1 = bf_lo4(xv[m][bj], 1) + acc[ai][bj][m][1] * scv[m];
                    *(f32x4*)op = r0; *(f32x4*)(op + 16) = r1; }
                __builtin_amdgcn_sched_barrier(0); }
            asm volatile("" ::: "memory"); }
    }
};
typedef short v4i16_t __attribute__((ext_vector_type(4)));
__device__ __forceinline__ void natten_phase(const Params& p, LAS unsigned char* lds, int G, int bx, int tid, int lane, int wave) {
    unsigned char* ws = p.ws;
    const bf16_t* Qg = (const bf16_t*)(ws + WS_Q); const bf16_t* Kg = (const bf16_t*)(ws + WS_K); const bf16_t* Vg = (const bf16_t*)(ws + WS_V); bf16_t* ATT = (bf16_t*)(ws + WS_ATT);
    const float* rp = (const float*)(ws + T_RPB);
    LAS float* biasT = (LAS float*)(lds + XTRA_OFF);
    const int j = lane & 15, q = lane >> 4, qq = j >> 2, pp = j & 3;
    constexpr int QOFF = XTRA_OFF + 4096;
    const int wv = __builtin_amdgcn_readfirstlane(wave);
    const int keyl = (wv & 3) * 8 + (lane >> 3), pch = lane & 7;
    const unsigned voK = (unsigned)(keyl * AW + ((pch ^ ((keyl >> 1) & 7)) << 3)) * 2u, voV = (unsigned)(keyl * AW + ((pch ^ (2 * ((keyl >> 1) & 3))) << 3)) * 2u;
    const unsigned voQ = (unsigned)((lane >> 3) * AW + pch * 8) * 2u, voB = (unsigned)lane * 4u;
#define NAT_PIECE(sb_expr_, vo_, ldsoff_, sz_) do { const char* sb_ = (sb_expr_); asm volatile("" : "+s"(sb_)); unsigned vv_ = (vo_); asm volatile("" : "+v"(vv_)); \
        __builtin_amdgcn_global_load_lds((const unsigned*)(sb_ + vv_), (LAS unsigned*)(lds + (ldsoff_)), sz_, 0, 0); } while (0)
#define NAT_DMA_KV(it2_, gbase_, ldsoff_, vo_) do { const int g2 = (it2_) & 3, rb2 = ((it2_) >> 2) & 15, h2 = ((it2_) >> 6) & 15, b2 = (it2_) >> 10; \
        const int base2 = min(max(8 * rb2 - 4, 0), 112), kcb2 = (g2 == 0) ? 0 : (g2 == 1) ? 8 : (g2 == 2) ? 24 : 32; \
        const char* sb0_ = (const char*)(gbase_) + (size_t)((((unsigned)b2 * SEQ + (base2 + (wv >> 2)) * 64 + kcb2) * AW + h2 * HD) * 2u); \
        _Pragma("unroll") for (int jj = 0; jj < 8; ++jj) NAT_PIECE(sb0_ + jj * 262144, vo_, (ldsoff_) + 8192 * jj + 1024 * wv, 16); } while (0)
#define NAT_DMA_QB(it2_) do { const int g2 = (it2_) & 3, rb2 = ((it2_) >> 2) & 15, h2 = ((it2_) >> 6) & 15, b2 = (it2_) >> 10; \
        const char* sq_ = (const char*)Qg + (size_t)((((unsigned)b2 * SEQ + (8 * rb2 + wv) * 64 + 16 * g2) * AW + h2 * HD) * 2u); \
        NAT_PIECE(sq_, voQ, QOFF + 2048 * wv, 16); NAT_PIECE(sq_ + 8 * AW * 2, voQ, QOFF + 2048 * wv + 1024, 16); \
        NAT_PIECE((const char*)rp + (size_t)((h2 * 465 + 64 * wv) * 4), voB, XTRA_OFF + 256 + 256 * wv, 4); } while (0)
    if (bx < 3072) { NAT_DMA_QB(bx); NAT_DMA_KV(bx, Kg, 0, voK); asm volatile("s_waitcnt vmcnt(0)" ::: "memory"); NAT_DMA_KV(bx, Vg, 65536, voV); }
    for (int it = bx; it < 3072; it += G) {
        const int g = it & 3, rb = (it >> 2) & 15, h = (it >> 6) & 15, b = it >> 10;
        const int base = min(max(8 * rb - 4, 0), 112), kcb = (g == 0) ? 0 : (g == 1) ? 8 : (g == 2) ? 24 : 32;
        const int itn = (it + G < 3072) ? it + G : it;
        asm volatile("s_waitcnt vmcnt(10)" ::: "memory");
        __builtin_amdgcn_s_barrier(); asm volatile("" ::: "memory");
        const int r = 8 * rb + wave, rs = min(max(r - 4, 0), 120), s0 = rs - base, c = 16 * g + j, cs = min(max(c - 8, 0), 48);
        bool sel[4]; int bix[4];
#pragma unroll
        for (int e = 0; e < 4; ++e) { const int kc0 = kcb + 4 * q + e; sel[e] = kc0 >= cs; bix[e] = 64 + (rs - r + 7) * 31 + 15 - c + kc0 + (sel[e] ? 0 : 16); }
        const unsigned m01 = (sel[0] ? 0xFFFFu : 0u) | (sel[1] ? 0xFFFF0000u : 0u), m23 = (sel[2] ? 0xFFFFu : 0u) | (sel[3] ? 0xFFFF0000u : 0u);
#define NAT_RD128(d_, a_, off_) asm volatile("ds_read_b128 %0, %1 offset:%2" : "=v"(d_) : "v"(a_), "n"(off_) : "memory")
#define NAT_RD32(d_, a_, off_) asm volatile("ds_read_b32 %0, %1 offset:%2" : "=v"(d_) : "v"(a_), "n"(off_) : "memory")
        const unsigned lb_ = (unsigned)(size_t)lds;
        unsigned kb_[2][2], bb_[4];
#pragma unroll
        for (int hf = 0; hf < 2; ++hf) { const int key = 16 * hf + j, ka = (s0 * 32 + key) * 128, sw = (key >> 1) & 7; kb_[hf][0] = lb_ + ka + ((q ^ sw) << 4); kb_[hf][1] = lb_ + ka + (((4 + q) ^ sw) << 4); }
#pragma unroll
        for (int e = 0; e < 4; ++e) bb_[e] = lb_ + XTRA_OFF + 4 * bix[e];
        bf16x8 qf0, qf1; { const unsigned qa_ = lb_ + QOFF + 2048 * wv + j * 128 + q * 16; NAT_RD128(qf0, qa_, 0); NAT_RD128(qf1, qa_, 64); }
        f32x4 S[8][2];
        bf16x8 kf[2][2][2]; float bz[2][4];
#define NAT_READS(bf_, a_) do { \
            NAT_RD128(kf[bf_][0][0], kb_[0][0], (a_) * 4096); NAT_RD128(kf[bf_][0][1], kb_[0][1], (a_) * 4096); NAT_RD128(kf[bf_][1][0], kb_[1][0], (a_) * 4096); NAT_RD128(kf[bf_][1][1], kb_[1][1], (a_) * 4096); \
            NAT_RD32(bz[bf_][0], bb_[0], (a_) * 124); NAT_RD32(bz[bf_][1], bb_[1], (a_) * 124); NAT_RD32(bz[bf_][2], bb_[2], (a_) * 124); NAT_RD32(bz[bf_][3], bb_[3], (a_) * 124); } while (0)
#define NAT_SCORE(bf_, a_, WAITSTR_) do { \
            asm volatile(WAITSTR_ : "+v"(kf[bf_][0][0]), "+v"(kf[bf_][0][1]), "+v"(kf[bf_][1][0]), "+v"(kf[bf_][1][1]), "+v"(bz[bf_][0]), "+v"(bz[bf_][1]), "+v"(bz[bf_][2]), "+v"(bz[bf_][3]), "+v"(qf0), "+v"(qf1) :: "memory"); \
            { const f32x4 bzv = {bz[bf_][0], bz[bf_][1], bz[bf_][2], bz[bf_][3]}; \
                _Pragma("unroll") for (int hf = 0; hf < 2; ++hf) { f32x4 z = __builtin_amdgcn_mfma_f32_16x16x32_bf16(kf[bf_][hf][0], qf0, bzv, 0, 0, 0); \
                    S[a_][hf] = __builtin_amdgcn_mfma_f32_16x16x32_bf16(kf[bf_][hf][1], qf1, z, 0, 0, 0); } } } while (0)
        NAT_READS(0, 0);
        NAT_READS(1, 1); NAT_SCORE(0, 0, "s_waitcnt lgkmcnt(8)"); NAT_READS(0, 2); NAT_SCORE(1, 1, "s_waitcnt lgkmcnt(8)"); NAT_READS(1, 3); NAT_SCORE(0, 2, "s_waitcnt lgkmcnt(8)");
        NAT_READS(0, 4); NAT_SCORE(1, 3, "s_waitcnt lgkmcnt(8)"); NAT_READS(1, 5); NAT_SCORE(0, 4, "s_waitcnt lgkmcnt(8)"); NAT_READS(0, 6); NAT_SCORE(1, 5, "s_waitcnt lgkmcnt(8)");
        NAT_READS(1, 7); NAT_SCORE(0, 6, "s_waitcnt lgkmcnt(8)"); NAT_SCORE(1, 7, "s_waitcnt lgkmcnt(0)");
#undef NAT_READS
#undef NAT_SCORE
#undef NAT_RD128
#undef NAT_RD32
        asm volatile("s_waitcnt vmcnt(0)" ::: "memory");
        __builtin_amdgcn_s_barrier(); asm volatile("" ::: "memory");
        NAT_DMA_QB(itn); NAT_DMA_KV(itn, Kg, 0, voK);
        f32x4 Sf[8]; float mx = -INFINITY;
#pragma unroll
        for (int a = 0; a < 8; ++a)
#pragma unroll
            for (int e = 0; e < 4; ++e) { const float sv = sel[e] ? S[a][0][e] : S[a][1][e]; Sf[a][e] = sv; mx = fmaxf(mx, sv); }
        mx = xmax32(xmax16(mx));
        float l = 0.f;
#pragma unroll
        for (int a = 0; a < 8; ++a)
#pragma unroll
            for (int e = 0; e < 4; ++e) { const float pv = __builtin_amdgcn_exp2f(Sf[a][e] - mx); Sf[a][e] = pv; l += pv; }
        l = xsum32(xsum16(l));
        f32x4 O[4];
#pragma unroll
        for (int dt = 0; dt < 4; ++dt) O[dt] = (f32x4){0.f, 0.f, 0.f, 0.f};
        unsigned vb_[4][2];
#pragma unroll
        for (int dt = 0; dt < 4; ++dt) { const int kk0 = 4 * q + qq, kk1 = 16 + 4 * q + qq, chunk = 2 * dt + (pp >> 1);
            vb_[dt][0] = (unsigned)(size_t)lds + 65536 + (s0 * 32 + kk0) * 128 + ((chunk ^ (2 * ((kk0 >> 1) & 3))) << 4) + (pp & 1) * 8;
            vb_[dt][1] = (unsigned)(size_t)lds + 65536 + (s0 * 32 + kk1) * 128 + ((chunk ^ (2 * ((kk1 >> 1) & 3))) << 4) + (pp & 1) * 8; }
        asm volatile("" : "+v"(vb_[0][0]), "+v"(vb_[0][1]), "+v"(vb_[1][0]), "+v"(vb_[1][1]), "+v"(vb_[2][0]), "+v"(vb_[2][1]), "+v"(vb_[3][0]), "+v"(vb_[3][1]));
#define NAT_TR(d_, a_, off_) asm volatile("ds_read_b64_tr_b16 %0, %1 offset:%2" : "=v"(d_) : "v"(a_), "n"(off_) : "memory")
        v4i16_t lo[2][4], hi[2][4];
#define NAT_READV(bf_, a_) do { NAT_TR(lo[bf_][0], vb_[0][0], (a_) * 4096); NAT_TR(hi[bf_][0], vb_[0][1], (a_) * 4096); NAT_TR(lo[bf_][1], vb_[1][0], (a_) * 4096); NAT_TR(hi[bf_][1], vb_[1][1], (a_) * 4096); \
            NAT_TR(lo[bf_][2], vb_[2][0], (a_) * 4096); NAT_TR(hi[bf_][2], vb_[2][1], (a_) * 4096); NAT_TR(lo[bf_][3], vb_[3][0], (a_) * 4096); NAT_TR(hi[bf_][3], vb_[3][1], (a_) * 4096); } while (0)
#define NAT_PV_ROW(a_, bf_, WAITSTR_) do { const unsigned p01 = g8::cvt_pk_bf16(Sf[a_][0], Sf[a_][1]), p23 = g8::cvt_pk_bf16(Sf[a_][2], Sf[a_][3]); \
            u32x4 pw; pw.x = p01 & m01; pw.y = p23 & m23; pw.z = p01 & ~m01; pw.w = p23 & ~m23; const bf16x8 pf = __builtin_bit_cast(bf16x8, pw); \
            asm volatile(WAITSTR_ : "+v"(lo[bf_][0]), "+v"(hi[bf_][0]), "+v"(lo[bf_][1]), "+v"(hi[bf_][1]), "+v"(lo[bf_][2]), "+v"(hi[bf_][2]), "+v"(lo[bf_][3]), "+v"(hi[bf_][3]) :: "memory"); \
            _Pragma("unroll") for (int dt = 0; dt < 4; ++dt) { const bf16x8 vf = (bf16x8){lo[bf_][dt][0], lo[bf_][dt][1], lo[bf_][dt][2], lo[bf_][dt][3], hi[bf_][dt][0], hi[bf_][dt][1], hi[bf_][dt][2], hi[bf_][dt][3]}; \
                O[dt] = __builtin_amdgcn_mfma_f32_16x16x32_bf16(vf, pf, O[dt], 0, 0, 0); } } while (0)
        NAT_READV(0, 0);
        NAT_READV(1, 1); NAT_PV_ROW(0, 0, "s_waitcnt lgkmcnt(8)"); NAT_READV(0, 2); NAT_PV_ROW(1, 1, "s_waitcnt lgkmcnt(8)"); NAT_READV(1, 3); NAT_PV_ROW(2, 0, "s_waitcnt lgkmcnt(8)");
        NAT_READV(0, 4); NAT_PV_ROW(3, 1, "s_waitcnt lgkmcnt(8)"); NAT_READV(1, 5); NAT_PV_ROW(4, 0, "s_waitcnt lgkmcnt(8)"); NAT_READV(0, 6); NAT_PV_ROW(5, 1, "s_waitcnt lgkmcnt(8)");
        NAT_READV(1, 7); NAT_PV_ROW(6, 0, "s_waitcnt lgkmcnt(8)"); NAT_PV_ROW(7, 1, "s_waitcnt lgkmcnt(0)");
#undef NAT_READV
#undef NAT_PV_ROW
#undef NAT_TR
        asm volatile("" ::: "memory"); __builtin_amdgcn_s_barrier(); asm volatile("" ::: "memory");
        const float il = __builtin_amdgcn_rcpf(l);
        bf16_t* op = ATT + ((size_t)b * SEQ + r * 64 + c) * ATT_LD + h * HD + 4 * q + ((q & 1) ? 12 : 0);
#pragma unroll
        for (int pr2 = 0; pr2 < 2; ++pr2) { const f32x4 o0 = O[2 * pr2] * il, o1 = O[2 * pr2 + 1] * il;
            const auto rx = __builtin_amdgcn_permlane16_swap(g8::cvt_pk_bf16(o0[0], o0[1]), g8::cvt_pk_bf16(o1[0], o1[1]), false, false);
            const auto ry = __builtin_amdgcn_permlane16_swap(g8::cvt_pk_bf16(o0[2], o0[3]), g8::cvt_pk_bf16(o1[2], o1[3]), false, false);
            u32x4 w; w.x = rx[0]; w.y = ry[0]; w.z = rx[1]; w.w = ry[1]; *(u32x4*)(op + 32 * pr2) = w; }
        NAT_DMA_KV(itn, Vg, 65536, voV);
    }
#undef NAT_DMA_KV
#undef NAT_DMA_QB
#undef NAT_PIECE
    asm volatile("s_waitcnt vmcnt(0)" ::: "memory");
    __syncthreads();
}

__device__ __forceinline__ int crow32(int g, int h) { return (g & 3) + 8 * (g >> 2) + 4 * h; }
__device__ __forceinline__ void fft_phase(const Params& p, LAS unsigned char* lds, int G, int bx, int tid, int lane, int wave) {
    unsigned char* ws = p.ws;
    const bf16_t* FT = (const bf16_t*)(ws + WS_FT); bf16_t* PT = (bf16_t*)(ws + WS_PT);
    const int r = lane & 31, h = lane >> 5, kb = wave & 3, chw = wave >> 2, li = lane & 15, qq = li >> 2, pp = li & 3, colhalf = (lane >> 4) & 1;
    LAS unsigned char* tbl = lds + XTRA_OFF + 4096;
    for (int i = tid; i < 27648 / 16; i += NTHR) *(LAS u32x4*)(tbl + 16 * i) = *(const u32x4*)(ws + T_F64 + 16 * i);
    bf16x8 Bc[8], Bs[8];
    { const bf16_t* fc = (const bf16_t*)(ws + T_F128C) + (32 * kb + r) * 128 + 8 * h; const bf16_t* fs = (const bf16_t*)(ws + T_F128S) + (32 * kb + r) * 128 + 8 * h;
#pragma unroll
      for (int ks = 0; ks < 8; ++ks) { Bc[ks] = *(const bf16x8*)(fc + 16 * ks); Bs[ks] = *(const bf16x8*)(fs + 16 * ks); } }
    unsigned twp[2][16];
#pragma unroll
    for (int mt = 0; mt < 2; ++mt)
#pragma unroll
        for (int g = 0; g < 16; ++g) { const int n2 = 32 * mt + crow32(g, h), k1 = 32 * kb + r; const float x = (float)((n2 * k1) & 8191) * (1.f / 8192.f); twp[mt][g] = g8::cvt_pk_bf16(__builtin_amdgcn_cosf(x), __builtin_amdgcn_sinf(x)); }
    __syncthreads();
    const int sw = ((qq >> 1) & 1) << 2;
    u32x4 v[4];
    auto issue = [&](int it2) { const bf16_t* src2 = FT + ((size_t)((it2 / 512) * FW + 2 * (it2 % 512))) * SEQ;
#pragma unroll
        for (int jj = 0; jj < 4; ++jj) v[jj] = *(const u32x4*)(src2 + (size_t)(tid + NTHR * jj) * 8); };
    if (bx < 1536) issue(bx);
    for (int it = bx; it < 1536; it += G) {
        const int b = it / 512, cp = it % 512, ch = 2 * cp + chw;
        __syncthreads();
#pragma unroll
        for (int jj = 0; jj < 4; ++jj) { const int pid = tid + NTHR * jj, chn = pid >> 10, n1 = (pid >> 3) & 127, c8 = pid & 7;
            *(LAS u32x4*)(lds + chn * 16384 + n1 * 128 + ((c8 ^ (((n1 >> 1) & 1) << 2)) << 4)) = v[jj]; }
        __syncthreads();
        if (it + G < 1536) issue(it + G);
        int frep_ = FFT_REP; asm volatile("" : "+s"(frep_));
        for (int rep_ = 0; rep_ < frep_; ++rep_) {
        f32x16 a1r[2], a1i[2];
#pragma unroll
        for (int mt = 0; mt < 2; ++mt)
#pragma unroll
            for (int g = 0; g < 16; ++g) { a1r[mt][g] = 0.f; a1i[mt][g] = 0.f; }
        {
            unsigned fa_[2];
#pragma unroll
            for (int mt = 0; mt < 2; ++mt) { const int c8 = 4 * mt + 2 * colhalf + (pp >> 1); fa_[mt] = (unsigned)(size_t)lds + chw * 16384 + (8 * h + qq) * 128 + ((c8 ^ sw) << 4) + (pp & 1) * 8; }
            v4i16_t lo[3][2], hi[3][2];
#define FFT_TR(d_, a_, off_) asm volatile("ds_read_b64_tr_b16 %0, %1 offset:%2" : "=v"(d_) : "v"(a_), "n"(off_) : "memory")
#define FFT_RD1(bf_, ks_) do { FFT_TR(lo[bf_][0], fa_[0], (ks_) * 2048); FFT_TR(hi[bf_][0], fa_[0], (ks_) * 2048 + 512); FFT_TR(lo[bf_][1], fa_[1], (ks_) * 2048); FFT_TR(hi[bf_][1], fa_[1], (ks_) * 2048 + 512); } while (0)
#define FFT_ST1(bf_, ks_, WAITSTR_) do { asm volatile(WAITSTR_ : "+v"(lo[bf_][0]), "+v"(hi[bf_][0]), "+v"(lo[bf_][1]), "+v"(hi[bf_][1]) :: "memory"); \
                _Pragma("unroll") for (int mt = 0; mt < 2; ++mt) { const bf16x8 A = (bf16x8){lo[bf_][mt][0], lo[bf_][mt][1], lo[bf_][mt][2], lo[bf_][mt][3], hi[bf_][mt][0], hi[bf_][mt][1], hi[bf_][mt][2], hi[bf_][mt][3]}; \
                    a1r[mt] = __builtin_amdgcn_mfma_f32_32x32x16_bf16(A, Bc[ks_], a1r[mt], 0, 0, 0); a1i[mt] = __builtin_amdgcn_mfma_f32_32x32x16_bf16(A, Bs[ks_], a1i[mt], 0, 0, 0); } } while (0)
            FFT_RD1(0, 0); FFT_RD1(1, 1);
            FFT_RD1(2, 2); FFT_ST1(0, 0, "s_waitcnt lgkmcnt(8)"); FFT_RD1(0, 3); FFT_ST1(1, 1, "s_waitcnt lgkmcnt(8)"); FFT_RD1(1, 4); FFT_ST1(2, 2, "s_waitcnt lgkmcnt(8)");
            FFT_RD1(2, 5); FFT_ST1(0, 3, "s_waitcnt lgkmcnt(8)"); FFT_RD1(0, 6); FFT_ST1(1, 4, "s_waitcnt lgkmcnt(8)"); FFT_RD1(1, 7); FFT_ST1(2, 5, "s_waitcnt lgkmcnt(8)");
            FFT_ST1(0, 6, "s_waitcnt lgkmcnt(4)"); FFT_ST1(1, 7, "s_waitcnt lgkmcnt(0)");
#undef FFT_ST1
#undef FFT_RD1
#undef FFT_TR
        }
        if (kb == 0) {
            float sg = 0.f;
#pragma unroll
            for (int mt = 0; mt < 2; ++mt)
#pragma unroll
                for (int g = 0; g < 16; ++g) sg += (g & 1) ? -a1r[mt][g] : a1r[mt][g];
            sg = xsum32(sg);
            if (lane == 0) ((float*)(ws + T_P4096))[b * FW + ch] = sg;
        }
        bf16x8 Br[2][2], Bi[2][2];
#pragma unroll
        for (int mt = 0; mt < 2; ++mt)
#pragma unroll
            for (int s = 0; s < 2; ++s) { u32x4 wr_, wi_;
#pragma unroll
                for (int e2 = 0; e2 < 4; ++e2) { const int g0 = 8 * s + 2 * e2, g1 = g0 + 1;
                    unsigned w0 = twp[mt][g0], w1 = twp[mt][g1]; asm volatile("" : "+v"(w0), "+v"(w1));
                    const float c0 = __uint_as_float(w0 << 16), s0_ = __uint_as_float(w0 & 0xffff0000u), c1 = __uint_as_float(w1 << 16), s1_ = __uint_as_float(w1 & 0xffff0000u);
                    const float xr0 = a1r[mt][g0] * c0 + a1i[mt][g0] * s0_, xi0 = a1i[mt][g0] * c0 - a1r[mt][g0] * s0_;
                    const float xr1 = a1r[mt][g1] * c1 + a1i[mt][g1] * s1_, xi1 = a1i[mt][g1] * c1 - a1r[mt][g1] * s1_;
                    wr_[e2] = g8::cvt_pk_bf16(xr0, xr1); wi_[e2] = g8::cvt_pk_bf16(xi0, xi1); }
                Br[mt][s] = __builtin_bit_cast(bf16x8, wr_); Bi[mt][s] = __builtin_bit_cast(bf16x8, wi_); }
        LAS unsigned char* stg = lds + 65536 + wave * 8192;
#pragma unroll
        for (int mt2 = 0; mt2 < 1; ++mt2) {
            f32x16 pr, pi;
#pragma unroll
            for (int g = 0; g < 16; ++g) { pr[g] = 0.f; pi[g] = 0.f; }
#pragma unroll
            for (int q4 = 0; q4 < 4; ++q4) { const int off = (32 * mt2 + r) * 144 + (q4 * 16 + 8 * h) * 2;
                bf16x8 Cf = *(const LAS bf16x8*)(tbl + off), Sf = *(const LAS bf16x8*)(tbl + 9216 + off), NSf = *(const LAS bf16x8*)(tbl + 18432 + off);
                asm volatile("" : "+v"(Cf), "+v"(Sf), "+v"(NSf));
                pr = __builtin_amdgcn_mfma_f32_32x32x16_bf16(Cf, Br[q4 >> 1][q4 & 1], pr, 0, 0, 0);
                pr = __builtin_amdgcn_mfma_f32_32x32x16_bf16(Sf, Bi[q4 >> 1][q4 & 1], pr, 0, 0, 0);
                pi = __builtin_amdgcn_mfma_f32_32x32x16_bf16(Cf, Bi[q4 >> 1][q4 & 1], pi, 0, 0, 0);
                pi = __builtin_amdgcn_mfma_f32_32x32x16_bf16(NSf, Br[q4 >> 1][q4 & 1], pi, 0, 0, 0); }
#pragma unroll
            for (int g = 0; g < 16; ++g) { const int row = 32 * mt2 + crow32(g, h);
                *(LAS bf16_t*)(stg + row * 64 + r * 2) = (bf16_t)(g8::cvt_pk_bf16(pr[g], pr[g]) & 0xffffu);
                *(LAS bf16_t*)(stg + 4096 + row * 64 + r * 2) = (bf16_t)(g8::cvt_pk_bf16(pi[g], pi[g]) & 0xffffu); }
        }
#pragma unroll
        for (int part = 0; part < 2; ++part)
#pragma unroll
            for (int st = 0; st < 2; ++st) { const int row = st * 16 + (lane >> 2), c4 = lane & 3;
                const u32x4 w = *(const LAS u32x4*)(stg + part * 4096 + row * 64 + c4 * 16);
                *(u32x4*)(PT + ((size_t)((b * 2 + part) * FW + ch)) * SEQ + 128 * row + 32 * kb + 8 * c4) = w; }
        }
    }
    __syncthreads();
}
__device__ __forceinline__ void ph_inproj(const Params& p, LAS unsigned char* lds, int G, int bx) {
    unsigned char* ws = p.ws;
    { typedef SchedP1 SG; SG S{(const char*)(ws + WS_XB), (const char*)(ws + WS_WIN), G, bx};
      if (threadIdx.x < 128) ((LAS float*)(lds + XTRA_OFF + 16384))[threadIdx.x] = threadIdx.x < 64 ? p.q_norm[threadIdx.x] : p.k_norm[threadIdx.x - 64];
      __syncthreads();
      EpiP1 E{ws, (bf16_t*)p.out, lds + XTRA_OFF};
      g8::gemm_phase<EpiP1, SG, D, D, true, KREP_[1]>(lds, S, E); }
}
__device__ __forceinline__ void ph_chdft(const Params& p, LAS unsigned char* lds, int G, int bx, int tid) {
    unsigned char* ws = p.ws;
    if (bx >= 244) {
        const int j = bx - 244, b = j >> 2, g = j & 3, c8 = tid & 31, cr = tid >> 5;
        const float* P4 = (const float*)(ws + T_P4096) + b * FW + g * 256 + cr * 16; const bf16_t* Tc = (const bf16_t*)(ws + T_DFTC) + (size_t)cr * 16 * 256 + 8 * c8;
        f32x4 s0 = {0.f, 0.f, 0.f, 0.f}, s1 = {0.f, 0.f, 0.f, 0.f};
#pragma unroll
        for (int q = 0; q < 16; ++q) { const float pv = P4[q]; const u32x4 w = *(const u32x4*)(Tc + q * 256); s0 += pv * bf_lo4(w, 0); s1 += pv * bf_lo4(w, 1); }
        LAS float* red = (LAS float*)lds;
        *(LAS f32x4*)(red + cr * 256 + 8 * c8) = s0; *(LAS f32x4*)(red + cr * 256 + 8 * c8 + 4) = s1;
        __syncthreads();
        if (tid < 256) { float t = 0.f;
#pragma unroll
            for (int q = 0; q < 16; ++q) t += red[q * 256 + tid];
            ((bf16_t*)(ws + WS_Y))[((size_t)b * SEQ + 4096) * FW + g * 256 + tid] = f2bf(t); }
        __syncthreads();
    }
    SchedChDft S{(const char*)(ws + WS_PT), (const char*)(ws + T_CS), G, bx};
    EpiChDft E{(bf16_t*)(ws + WS_Y)};
    g8::gemm_phase<EpiChDft, SchedChDft, SEQ, 512, false, 1, true>(lds, S, E);
}
__device__ __forceinline__ void ph_merge(const Params& p, LAS unsigned char* lds, int G, int bx) {
    unsigned char* ws = p.ws;
    SchedMerge2 S{(const char*)(ws + WS_Y), (const char*)(ws + WS_ATT), (const char*)(ws + WS_WFO), (const char*)(ws + WS_WAO), G, bx};
    EpiMergeBr E{EpiMerge{ws, (const bf16_t*)p.out}};
    g8::gemm_phase<EpiMergeBr, SchedMerge2, 1024, 1024, false, KREP_[4], false>(lds, S, E);
}
__device__ __forceinline__ void ph_outproj(const Params& p, LAS unsigned char* lds, int G, int bx) {
    unsigned char* ws = p.ws;
    typedef SchedGrid<M / 256, D / 256, D / 64, D, D> SG; SG S{(const char*)(ws + WS_MERGED), (const char*)(ws + WS_WOUT), G, bx};
    EpiX1 E{XIn{p.xp, p.xs}, ws};
    g8::gemm_phase<EpiX1, SG, D, D, false, KREP_[5]>(lds, S, E);
}
__device__ __forceinline__ void ph_up(const Params& p, LAS unsigned char* lds, int G, int bx, int vcu, int tid) {
    unsigned char* ws = p.ws;
    {
        const float* SSQ = (const float*)(ws + WS_SSQ); float* r2 = (float*)(ws + T_RSTD2);
        for (int r = vcu * NTHR + tid; r < M; r += G * NTHR) { const f32x4* q = (const f32x4*)(SSQ + (size_t)r * 32); float s = 0.f;
#pragma unroll
            for (int j = 0; j < 8; ++j) { const f32x4 v = q[j]; s += (v[0] + v[1]) + (v[2] + v[3]); }
            r2[r] = 1.f / (s * (1.f / D) + EPS); }
    }
    typedef SchedGrid<M / 256, DFF / 256, D / 64, D, D> SG; SG S{(const char*)(ws + WS_X1B), (const char*)(ws + WS_W1), G, bx};
    EpiRelu2 E{(bf16_t*)(ws + WS_U), (bf16_t*)p.out};
    g8::gemm_phase<EpiRelu2, SG, D, D, false, KREP_[6]>(lds, S, E);
}
__device__ __forceinline__ void ph_down(const Params& p, LAS unsigned char* lds, int G, int bx) {
    unsigned char* ws = p.ws;
    SchedDown S{(const char*)(ws + WS_U), (const char*)p.out, (const char*)(ws + WS_W2), G, bx};
    EpiDown E{p.out, ws, (unsigned*)(ws + WS_CTL) + CW_PANEL};
    g8::gemm_phase<EpiDown, SchedDown, 4096, DFF, false, KREP_[7]>(lds, S, E);
}

__global__ void __launch_bounds__(NTHR, 2) __attribute__((target("no-packed-fp32-ops"))) mk_fwd(Params p) {
    extern __shared__ __attribute__((aligned(16))) unsigned char lds_raw[];
    LAS unsigned char* lds = (LAS unsigned char*)lds_raw;
    const int tid = threadIdx.x, lane = tid & 63, wave = __builtin_amdgcn_readfirstlane(tid >> 6);
    const int G = gridDim.x, bx = blockIdx.x;
    const int vcu = (G % 8 == 0) ? (bx % 8) * (G / 8) + bx / 8 : bx;
    const int gw = vcu * NWAVES + wave, NGW = G * NWAVES;
    unsigned char* ws = p.ws;
    volatile LAS unsigned* MISC = (volatile LAS unsigned*)(lds + LDSCTL_OFF);
    if (tid < 64) MISC[tid] = 0u;
    __syncthreads();
    unsigned* ctl = (unsigned*)(ws + WS_CTL);
    XcdBarrier bar = xcd_barrier_post(ctl + CW_BAR + p.li * XCD_BAR_WORDS, MISC + 8);
    const int lo = p.ph_lo, hi = p.ph_hi;
#define IN(k) (lo <= (k) && (k) < hi)
#define SEAM(k) do { if (IN(k) && IN((k) + 1)) xcd_barrier(bar); } while (0)

#define PHASE(k, body) do { if (IN(k)) { body; } SEAM(k); } while (0)
    PHASE(0, p0_prologue(p, lds, gw, NGW, lane, wave));
    PHASE(1, ph_inproj(p, lds, G, bx));
    PHASE(2, { const bool fft_first = bx & 1;     if (!fft_first) natten_phase(p, lds, G, vcu, tid, lane, wave); fft_phase(p, lds, G, bx, tid, lane, wave); if (fft_first) natten_phase(p, lds, G, vcu, tid, lane, wave); });
    PHASE(3, ph_chdft(p, lds, G, bx, tid));
    PHASE(4, ph_merge(p, lds, G, bx));
    PHASE(5, ph_outproj(p, lds, G, bx));
    PHASE(6, ph_up(p, lds, G, bx, vcu, tid));
    PHASE(7, ph_down(p, lds, G, bx));
#ifdef MK_PROBE_SUBPHASES
    if (IN(8)) { fft_phase(p, lds, G, bx, tid, lane, wave); }
    if (IN(9)) { natten_phase(p, lds, G, bx, tid, lane, wave); }
#endif
#undef PHASE
#undef IN
#undef SEAM
}

extern "C" void kernel_launch(void* const* d_in, const int* in_sizes, int n_in, void* d_out, int out_size, void* d_ws, size_t ws_size, hipStream_t stream) {
    static int grid = 0;
    if (grid == 0) {
        if (n_in != 13 || ws_size < WS_END || out_size != M * D) { fprintf(stderr, "kernel_launch: unexpected sizes n_in %d ws %zu out %d\n", n_in, ws_size, out_size); grid = -1; return; }
        int dev = 0, cus = 0, per_cu = 0;
        if (hipGetDevice(&dev) != hipSuccess || hipDeviceGetAttribute(&cus, hipDeviceAttributeMultiprocessorCount, dev) != hipSuccess) { grid = -1; return; }
        if (hipFuncSetAttribute((const void*)mk_fwd, hipFuncAttributeMaxDynamicSharedMemorySize, LDS_BYTES) != hipSuccess) { fprintf(stderr, "kernel_launch: hipFuncSetAttribute failed\n"); grid = -1; return; }
        if (hipOccupancyMaxActiveBlocksPerMultiprocessor(&per_cu, (const void*)mk_fwd, NTHR, LDS_BYTES) != hipSuccess || per_cu < 1) fprintf(stderr, "kernel_launch: occupancy query says %d\n", per_cu);
        (void)hipGetLastError();
        grid = cus;
        if (grid != 256) { fprintf(stderr, "kernel_launch: built for a 256-CU device (MI355X), found %d CUs; nothing launched\n", cus); grid = -1; return; }
    }
    if (grid < 0) return;
    const float* xp = (const float*)d_in[0]; const float* xs = (const float*)d_in[1];
    const float* g_mix = (const float*)d_in[2]; const float* w_in = (const float*)d_in[3];
    const float* q_norm = (const float*)d_in[4]; const float* k_norm = (const float*)d_in[5]; const float* rpb = (const float*)d_in[6];
    const float* w_fo = (const float*)d_in[7]; const float* w_ao = (const float*)d_in[8]; const float* w_out = (const float*)d_in[9];
    const float* g_mlp = (const float*)d_in[10]; const float* w1 = (const float*)d_in[11]; const float* w2 = (const float*)d_in[12];
    unsigned char* ws = (unsigned char*)d_ws; float* out = (float*)d_out;

    hipMemsetAsync(ws + WS_CTL, 0, CTL_ZERO_BYTES, stream);
    Params prm{}; prm.xp = xp; prm.xs = xs; prm.g_mix = g_mix; prm.w_in = w_in; prm.q_norm = q_norm; prm.k_norm = k_norm; prm.rpb = rpb; prm.w_fo = w_fo; prm.w_ao = w_ao; prm.w_out = w_out;
    prm.g_mlp = g_mlp; prm.w1 = w1; prm.w2 = w2; prm.out = out; prm.ws = ws;
    int n_mk = 0;
#define MK(lo_, hi_) do { prm.ph_lo = lo_; prm.ph_hi = hi_; prm.li = n_mk++; hipLaunchKernelGGL(mk_fwd, dim3(grid), dim3(NTHR), LDS_BYTES, stream, prm); } while (0)
    constexpr int PLAN[][2] = {{0, 8}};
    for (auto& pl : PLAN) MK(pl[0], pl[1]);
}
```

```cpp
#include <hip/hip_runtime.h>
#include <cstdio>
#include <cstdint>

typedef unsigned short bf16_t;
typedef short bf16x8 __attribute__((ext_vector_type(8)));
typedef short s16x4 __attribute__((ext_vector_type(4)));
typedef float f32x2 __attribute__((ext_vector_type(2)));
typedef float f32x4 __attribute__((ext_vector_type(4)));
typedef float f32x16 __attribute__((ext_vector_type(16)));
typedef unsigned u32x2 __attribute__((ext_vector_type(2)));
typedef unsigned u32x4 __attribute__((ext_vector_type(4)));
#define LAS __attribute__((address_space(3)))
#define GAS __attribute__((address_space(1)))

constexpr int D = 2048, SEQ = 8192, NB = 3, M = NB * SEQ;
constexpr int NH = 16, HD = 64, AW = 1024, FW = 1024, INW = 8192, DFF = 8192;
constexpr float EPS = 1e-6f;
constexpr float LOG2E = 1.4426950408889634f;
constexpr float QSCALE = 0.125f * LOG2E;
constexpr float S_ORTHO = 6.905339660024878e-4f;

constexpr size_t MiB = 1u << 20;
constexpr size_t WS_CTL = 0, CTL_ZERO_BYTES = 65536;
constexpr size_t WS_TAB = 1 * MiB;
constexpr size_t T_RSTD1 = WS_TAB, T_RSTD2 = WS_TAB + 98304;
constexpr size_t T_DFTC = WS_TAB + 196608, T_DFTS = WS_TAB + 327680;
constexpr size_t T_F128C = WS_TAB + 458752, T_F128S = WS_TAB + 491520;
constexpr size_t T_F64 = WS_TAB + 524288;
constexpr size_t T_RPB = WS_TAB + 557056;
constexpr size_t T_TW = WS_TAB + 589824;
constexpr size_t T_CS = WS_TAB + 1048576;
constexpr size_t T_P4096 = WS_TAB + 1048576 + 524288;
constexpr size_t WS_SSQ = 3 * MiB;
constexpr size_t WS_WIN = 6 * MiB, WS_WFO = 38 * MiB, WS_WAO = 42 * MiB, WS_WOUT = 54 * MiB, WS_W1 = 62 * MiB, WS_W2 = 94 * MiB;
constexpr size_t WS_B = 126 * MiB, WS_Q = WS_B, WS_K = WS_B + 48 * MiB, WS_V = WS_B + 96 * MiB, WS_MERGED = WS_B;
constexpr size_t WS_A = 270 * MiB, WS_XB = WS_A, WS_PT = WS_A;
constexpr size_t WS_C = 366 * MiB, WS_FT = WS_C, WS_FM = WS_C;
constexpr size_t WS_D = 414 * MiB, WS_ATT = WS_D, WS_X1B = WS_D;
constexpr size_t WS_U = 126 * MiB;
constexpr size_t WS_TMP0 = 6 * MiB, WS_TMP1 = 318 * MiB;
constexpr size_t WS_END = 510 * MiB;
constexpr int ATT_LD = 1024;
constexpr size_t WS_Y = 366 * MiB;

__device__ __forceinline__ float bf2f(bf16_t v) { return __uint_as_float((unsigned)v << 16); }
__device__ __forceinline__ bf16_t f2bf(float f) { unsigned u = __float_as_uint(f); return (bf16_t)((u + 0x7fffu + ((u >> 16) & 1u)) >> 16); }
__device__ __forceinline__ unsigned pk2(float lo, float hi) { return (unsigned)f2bf(lo) | ((unsigned)f2bf(hi) << 16); }

struct XIn { const float* xp; const float* xs; __device__ __forceinline__ const float* row(int m) const { return m < SEQ ? xp + (size_t)m * D : xs + (size_t)(m - SEQ) * D; } };

namespace g8 {
constexpr int BM = 256, BK = 64, HALF = 128, HTB = HALF * BK * 2, STAGE_BYTES = 8 * HTB, NXCD = 8, WGM = 4;

__host__ __device__ __forceinline__ int lds_byte(int r, int c) { const int st = (r >> 4) * 2 + (c >> 5), rr = r & 15, cc = c & 31, ob = rr * 64 + cc * 2; return st * 1024 + (ob ^ (((ob >> 9) & 1) << 5)); }
__host__ __device__ __forceinline__ void stage_rc(int b, int& R, int& C) { const int st = b / 1024, sb = b % 1024, swz = sb ^ (((sb >> 9) & 1) << 5); R = (st >> 1) * 16 + swz / 64; C = (st & 1) * 32 + (swz % 64) / 2; }
__host__ __device__ __forceinline__ int perm32(int rho) { const int n = rho >> 4, i = rho & 15; return 8 * (i >> 2) + 4 * n + (i & 3); }

struct Unit { const char* a; const char* b; int pm, pn, nt, keep, br; };

template <int WG = WGM> __device__ __forceinline__ void tile_of(int L, int nM, int nN, int& pm, int& pn) {
    const int nwg = nM * nN; int wgid = L;
    { const int q = nwg / NXCD, r = nwg % NXCD, xcd = wgid % NXCD, off = wgid / NXCD; wgid = (xcd < r ? xcd * (q + 1) : r * (q + 1) + (xcd - r) * q) + off; }
    const int nig = WG * nN, gid = wgid / nig, fm = gid * WG, gsz = (nM - fm) < WG ? (nM - fm) : WG;
    pm = fm + ((wgid % nig) % gsz); pn = (wgid % nig) / gsz;
}

typedef __bf16 bf16x2_t __attribute__((ext_vector_type(2)));
__device__ __forceinline__ unsigned cvt_pk_bf16(float lo, float hi) { f32x2 v = {lo, hi}; bf16x2_t b = __builtin_convertvector(v, bf16x2_t); return __builtin_bit_cast(unsigned, b); }

template <bool HEAD64> __device__ __forceinline__ int colbase(int bj, int wc, int fq) { return HEAD64 ? (64 * wc + 32 * bj + 8 * fq) : (128 * bj + 32 * wc + 8 * fq); }

template <class Epi, class Sched, int lda, int ldb, bool HEAD64, int KREP = 1, bool AKM = false>
__device__ __forceinline__ void gemm_phase(LAS unsigned char* lds, const Sched& S, const Epi& E) {
    const int tid = threadIdx.x, wid = __builtin_amdgcn_readfirstlane(tid >> 6), lane = tid & 63, wr = wid >> 2, wc = wid & 3, fr = lane & 15, fq = lane >> 4;
    Unit cur, nxt; int ui = 0; bool prev_keep = false;
    if (!S.next(0, cur)) return;
    unsigned voffB[2], voffA[2];
#pragma unroll
    for (int i = 0; i < 2; ++i) { int R, C; stage_rc(tid * 16 + i * 8192, R, C);
        const int Rb = HEAD64 ? ((R >> 5) * 64 + perm32(R & 31)) : ((R & ~31) + perm32(R & 31));
        voffB[i] = (unsigned)(Rb * ldb + C) * 2u; voffA[i] = (unsigned)(R * lda + C) * 2u;
        if (AKM) { const int pb = tid * 16 + i * 8192, krow = pb >> 8, c16s = (pb >> 4) & 15, f = (krow & 3) | (((krow >> 3) & 1) << 2), c16 = (((c16s >> 1) ^ f) << 1) | (c16s & 1);
            voffA[i] = (unsigned)(krow * lda + c16 * 8) * 2u; } }
    const size_t kstep = (size_t)(BK * 2), kstepA = AKM ? (size_t)BK * lda * 2 : kstep;
    const size_t hB = (size_t)(HEAD64 ? 32 : HALF) * ldb * 2;
    const size_t hA = AKM ? (size_t)HALF * 2 : (size_t)HALF * lda * 2;
    const int akoff = ((8 * fq + (fr >> 2)) << 8) + 8 * (fr & 3), akf = (fr >> 2) | ((fq & 1) << 2);
    const unsigned ldsw = (unsigned)wid * 1024u;
    const int aoff = lds_byte(wr * 64 + fr, fq * 8), boff = lds_byte(wc * 32 + fr, fq * 8);
#define G8_SA(b, h) (((b) * 2 + (h)) * HTB)
#define G8_SB(b, h) ((4 + (b) * 2 + (h)) * HTB)
#define G8_STAGE(bufoff, gbase, voff) do { const char* sb_ = (const char*)(gbase); asm volatile("" : "+s"(sb_));     \
        _Pragma("unroll") for (int _i = 0; _i < 2; ++_i) { unsigned vo_ = (voff)[_i]; asm volatile("" : "+v"(vo_));     \
        __builtin_amdgcn_global_load_lds((const unsigned*)(sb_ + vo_), (LAS unsigned*)(lds + (bufoff) + ldsw + _i * 8192), 16, 0, 0); } } while (0)
#define G8_TR(d_, a_, off_) asm volatile("ds_read_b64_tr_b16 %0, %1 offset:%2" : "=v"(d_) : "v"(a_), "n"(off_) : "memory")
#define G8_PINA do { if constexpr (AKM) asm volatile("s_waitcnt lgkmcnt(0)" : "+v"(At[0][0]), "+v"(At[0][1]), "+v"(At[1][0]), "+v"(At[1][1]), "+v"(At[2][0]), "+v"(At[2][1]), "+v"(At[3][0]), "+v"(At[3][1]) :: "memory"); } while (0)
#define G8_LDA(dst, b, h) do { if constexpr (!AKM) { _Pragma("unroll") for (int m = 0; m < 4; ++m) _Pragma("unroll") for (int k = 0; k < 2; ++k) dst[m][k] = *(const LAS bf16x8*)(lds + G8_SA(b, h) + aoff + m * 2048 + k * 1024); } \
    else { _Pragma("unroll") for (int m = 0; m < 4; ++m) { const unsigned ab_ = (unsigned)(size_t)lds + (unsigned)(akoff + (((4 * wr + m) ^ akf) << 5)); s16x4 l0_, h0_, l1_, h1_; \
        G8_TR(l0_, ab_, G8_SA(b, h)); G8_TR(h0_, ab_, G8_SA(b, h) + 1024); G8_TR(l1_, ab_, G8_SA(b, h) + 8192); G8_TR(h1_, ab_, G8_SA(b, h) + 8192 + 1024); \
        dst[m][0] = (bf16x8){l0_[0], l0_[1], l0_[2], l0_[3], h0_[0], h0_[1], h0_[2], h0_[3]}; dst[m][1] = (bf16x8){l1_[0], l1_[1], l1_[2], l1_[3], h1_[0], h1_[1], h1_[2], h1_[3]}; } } } while (0)
#define G8_LDB(dst, b, h) do { _Pragma("unroll") for (int n = 0; n < 2; ++n) _Pragma("unroll") for (int k = 0; k < 2; ++k) dst[n][k] = *(const LAS bf16x8*)(lds + G8_SB(b, h) + boff + n * 2048 + k * 1024); } while (0)
#define G8_MMA(ai, bj, At, Bt) do { __builtin_amdgcn_s_setprio(1); _Pragma("unroll") for (int m = 0; m < 4; ++m) _Pragma("unroll") for (int n = 0; n < 2; ++n) _Pragma("unroll") for (int k = 0; k < 2; ++k) \
        acc[ai][bj][m][n] = __builtin_amdgcn_mfma_f32_16x16x32_bf16(Bt[n][k], At[m][k], acc[ai][bj][m][n], 0, 0, 0); __builtin_amdgcn_s_setprio(0); } while (0)
#define G8_WAIT_V(n) asm volatile("s_waitcnt vmcnt(" #n ")" ::: "memory")
#define G8_WAIT_L(n) asm volatile("s_waitcnt lgkmcnt(" #n ")" ::: "memory")
#define G8_BAR __builtin_amdgcn_s_barrier()
#define G8_SCHED __builtin_amdgcn_sched_barrier(0)
    f32x4 acc[2][2][4][2];
#pragma unroll
    for (int a = 0; a < 2; ++a)
#pragma unroll
        for (int b = 0; b < 2; ++b)
#pragma unroll
            for (int m = 0; m < 4; ++m)
#pragma unroll
                for (int n = 0; n < 2; ++n) acc[a][b][m][n] = (f32x4){0.f, 0.f, 0.f, 0.f};
    bf16x8 At[4][2], B0[2][2], B1[2][2];
    const char* cA = cur.a; const char* cB = cur.b;
    G8_STAGE(G8_SB(0, 0), cB, voffB); G8_STAGE(G8_SB(0, 1), cB + hB, voffB); G8_STAGE(G8_SA(0, 0), cA, voffA); G8_STAGE(G8_SA(0, 1), cA + hA, voffA);
    if (wr == 1) G8_BAR;
    G8_WAIT_V(2); G8_BAR;
    G8_STAGE(G8_SB(1, 0), cB + kstep, voffB); G8_STAGE(G8_SA(1, 0), cA + kstepA, voffA); G8_STAGE(G8_SB(1, 1), cB + hB + kstep, voffB);
    G8_WAIT_V(6); G8_BAR;
    for (;;) {
        const bool has_next = S.next(ui + 1, nxt);
        const char* nA = has_next ? nxt.a : cA; const char* nB = has_next ? nxt.b : cB;
        const int nt1 = cur.nt, nt = nt1 * KREP;
        for (int t = 0; t < nt; t += 2) {
            const bool last = (t == nt - 2);
            const int t1 = (KREP > 1 && t + 1 >= nt1) ? t + 1 - nt1 : t + 1, t2 = (KREP > 1 && t + 2 >= nt1) ? t + 2 - nt1 : t + 2;
            const char* a1 = cA + (size_t)t1 * kstepA;
            const char* a2 = last ? nA : cA + (size_t)t2 * kstepA; const char* b2 = last ? nB : cB + (size_t)t2 * kstep;
            const char* a3 = a2 + kstepA; const char* b3 = b2 + kstep;
            const bool relax = (t == 0) && (ui > 0) && !(Sched::HAS_KEEP && prev_keep);
            G8_LDB(B0, 0, 0); G8_LDB(B1, 0, 1); G8_SCHED; G8_LDA(At, 0, 0); G8_STAGE(G8_SA(1, 1), a1 + hA, voffA);
            if (relax) G8_WAIT_V(24); else G8_WAIT_V(8);
            G8_WAIT_L(0); G8_PINA; G8_BAR; G8_MMA(0, 0, At, B0); G8_MMA(0, 1, At, B1); G8_BAR; G8_SCHED;
            G8_LDA(At, 0, 1); G8_STAGE(G8_SB(0, 0), b2, voffB); G8_STAGE(G8_SB(0, 1), b2 + hB, voffB); G8_STAGE(G8_SA(0, 0), a2, voffA);
            if (relax) G8_WAIT_V(24); else G8_WAIT_V(8);
            G8_WAIT_L(0); G8_PINA; G8_BAR; G8_MMA(1, 0, At, B0); G8_MMA(1, 1, At, B1); G8_BAR; G8_SCHED;
            G8_LDB(B0, 1, 0); G8_LDB(B1, 1, 1); G8_SCHED; G8_LDA(At, 1, 0); G8_STAGE(G8_SA(0, 1), a2 + hA, voffA);
            G8_WAIT_V(8); G8_WAIT_L(0); G8_PINA; G8_BAR; G8_MMA(0, 0, At, B0); G8_MMA(0, 1, At, B1); G8_BAR; G8_SCHED;
            G8_LDA(At, 1, 1); G8_STAGE(G8_SB(1, 0), b3, voffB); G8_STAGE(G8_SB(1, 1), b3 + hB, voffB); G8_STAGE(G8_SA(1, 0), a3, voffA);
            G8_WAIT_V(8); G8_WAIT_L(0); G8_PINA; G8_BAR; G8_MMA(1, 0, At, B0); G8_MMA(1, 1, At, B1); G8_BAR; G8_SCHED;
        }
        if (wr == 0) G8_BAR;
        if (KREP > 1) {
#pragma unroll
            for (int a = 0; a < 2; ++a)
#pragma unroll
                for (int b = 0; b < 2; ++b)
#pragma unroll
                    for (int m = 0; m < 4; ++m)
#pragma unroll
                        for (int n = 0; n < 2; ++n) acc[a][b][m][n] *= (1.f / KREP); }
        E(acc, cur, wr, wc, fr, fq);
        if (!has_next) break;
        if constexpr (Sched::HAS_KEEP) prev_keep = cur.keep != 0;
        if (!(Sched::HAS_KEEP && prev_keep)) {
#pragma unroll
        for (int a = 0; a < 2; ++a)
#pragma unroll
            for (int b = 0; b < 2; ++b)
#pragma unroll
                for (int m = 0; m < 4; ++m)
#pragma unroll
                    for (int n = 0; n < 2; ++n) acc[a][b][m][n] = (f32x4){0.f, 0.f, 0.f, 0.f};
        }
        cur = nxt; cA = nA; cB = nB; ++ui;
        if (wr == 1) G8_BAR;
    }
    G8_WAIT_V(0);
    G8_BAR;
#undef G8_SA
#undef G8_SB
#undef G8_STAGE
#undef G8_LDA
#undef G8_TR
#undef G8_PINA
#undef G8_LDB
#undef G8_MMA
#undef G8_WAIT_V
#undef G8_WAIT_L
#undef G8_BAR
#undef G8_SCHED
}
}

#define XB_TMO      128
#define XB_XCNT(j)  (256  + 64 * (j))
#define XB_XSUB(j)  (1280 + 64 * (j))
#define XB_XGEN(j)  (2304 + 64 * (j))
#define XB_TOP      3328
#define XB_TOPGEN   3392
#define XCD_BAR_WORDS 3456
#define XB_SPIN_CAP (1u << 18)

__device__ __forceinline__ unsigned xb_ld(unsigned* p)              { return __hip_atomic_load(p, __ATOMIC_RELAXED, __HIP_MEMORY_SCOPE_AGENT); }
__device__ __forceinline__ unsigned xb_add(unsigned* p, unsigned v) { return __hip_atomic_fetch_add(p, v, __ATOMIC_RELAXED, __HIP_MEMORY_SCOPE_AGENT); }
__device__ __forceinline__ unsigned xb_xcc_id() { return (unsigned)__builtin_amdgcn_s_getreg((3 << 11) | 20) & 0xFu; }
#define XB_SPIN(cond, bar) do { unsigned _sp = 0; while (cond) { __builtin_amdgcn_s_sleep(1); \
    if ((++_sp & 255u) == 0u) { if (xb_ld(&(bar)[XB_TMO])) break; if (_sp > XB_SPIN_CAP) { atomicAdd(&(bar)[XB_TMO], 1u); break; } } } } while (0)

struct XcdBarrier { unsigned* bar; unsigned x; volatile LAS unsigned* st; };

__device__ __forceinline__ XcdBarrier xcd_barrier_post(unsigned* bar, volatile LAS unsigned* st) {
    XcdBarrier b; b.bar = bar; b.x = xb_xcc_id(); b.st = st;
    if (threadIdx.x == 0) (void)xb_add(&bar[XB_XCNT(b.x)], 1u);
    return b;
}
__device__ __forceinline__ void xcd_barrier_complete(unsigned* bar, unsigned x, unsigned& nloc, unsigned& nx) {
    const unsigned G = gridDim.x * gridDim.y * gridDim.z;
    unsigned sum, cnt, mine, sp = 0u;
    for (;;) {
        sum = 0u; cnt = 0u; mine = 0u;
#pragma unroll
        for (unsigned j = 0; j < 16; ++j) { const unsigned c = xb_ld(&bar[XB_XCNT(j)]); sum += c; cnt += (c > 0u) ? 1u : 0u; mine = (j == x) ? c : mine; }
        if (sum == G) break;
        __builtin_amdgcn_s_sleep(1);
        if ((++sp & 255u) == 0u) { if (xb_ld(&bar[XB_TMO])) break; if (sp > XB_SPIN_CAP) { atomicAdd(&bar[XB_TMO], 1u); break; } }
    }
    nloc = mine > 0u ? mine : 1u; nx = cnt > 0u ? cnt : 1u;
}
__device__ __forceinline__ void xcd_barrier(const XcdBarrier& b) {
    asm volatile("s_waitcnt vmcnt(0)" ::: "memory");
    __syncthreads();
    if (threadIdx.x == 0) {
        unsigned* bar = b.bar;
        __builtin_amdgcn_s_waitcnt(0);
        unsigned nloc = b.st[0], nx = b.st[1];
        if (nloc == 0u) { xcd_barrier_complete(bar, b.x, nloc, nx); b.st[0] = nloc; b.st[1] = nx; }
        const unsigned old = xb_add(&bar[XB_XSUB(b.x)], 1u);
        const unsigned gen = old / nloc;
        if (old + 1u == (gen + 1u) * nloc) {
            __builtin_amdgcn_fence(__ATOMIC_RELEASE, "agent");
            asm volatile("s_waitcnt vmcnt(0)" ::: "memory");
            const unsigned og = xb_add(&bar[XB_TOP], 1u);
            const unsigned tg = og / nx;
            if (og + 1u == (tg + 1u) * nx) xb_add(&bar[XB_TOPGEN], 1u);
            else XB_SPIN(xb_ld(&bar[XB_TOPGEN]) == tg, bar);
            __builtin_amdgcn_fence(__ATOMIC_ACQUIRE, "agent");
            xb_add(&bar[XB_XGEN(b.x)], 1u);
            asm volatile("s_waitcnt vmcnt(0)" ::: "memory");
        } else {
            XB_SPIN(xb_ld(&bar[XB_XGEN(b.x)]) == gen, bar);
            __builtin_amdgcn_fence(__ATOMIC_ACQUIRE, "agent");
            asm volatile("s_waitcnt vmcnt(0)" ::: "memory");
        }
    }
    __syncthreads();
}

constexpr int NWAVES = 8, NTHR = 512;
constexpr int RING_BYTES = 131072, XTRA_OFF = RING_BYTES, LDSCTL_OFF = 163840 - 256, LDS_BYTES = 163840;
constexpr int CW_BAR = 4096, CW_PANEL = 12288;
constexpr int NPH = 8;
constexpr int NAT_REP = 1;
constexpr int FFT_REP = 1;
constexpr int KREP_[NPH] = {1, 1, 1, 1, 1, 1, 1, 1};

struct Params { const float *xp, *xs, *g_mix, *w_in, *q_norm, *k_norm, *rpb, *w_fo, *w_ao, *w_out, *g_mlp, *w1, *w2; float* out; unsigned char* ws; int ph_lo, ph_hi, li, pad; };

__device__ __forceinline__ float xsum16(float v) { const auto r = __builtin_amdgcn_permlane16_swap(__float_as_uint(v), __float_as_uint(v), false, false); return __uint_as_float(r[0]) + __uint_as_float(r[1]); }
__device__ __forceinline__ float xsum32(float v) { const auto r = __builtin_amdgcn_permlane32_swap(__float_as_uint(v), __float_as_uint(v), false, false); return __uint_as_float(r[0]) + __uint_as_float(r[1]); }
__device__ __forceinline__ float xmax16(float v) { const auto r = __builtin_amdgcn_permlane16_swap(__float_as_uint(v), __float_as_uint(v), false, false); return fmaxf(__uint_as_float(r[0]), __uint_as_float(r[1])); }
__device__ __forceinline__ float xmax32(float v) { const auto r = __builtin_amdgcn_permlane32_swap(__float_as_uint(v), __float_as_uint(v), false, false); return fmaxf(__uint_as_float(r[0]), __uint_as_float(r[1])); }
__device__ __forceinline__ float wave_sum(float v) {
#pragma unroll
    for (int o = 1; o < 64; o <<= 1) v += __shfl_xor(v, o);
    return v;
}
#define LDS_WAIT() asm volatile("s_waitcnt lgkmcnt(0)" ::: "memory")

struct WItem { const float* src; const float* gain; bf16_t* dst; int N, ldo; float sc; };
__device__ __forceinline__ bool p0_resolve(const Params& p, int it, WItem& w) {
    unsigned char* ws = p.ws;
    constexpr int I_IN = (D / 64) * (INW / 32), I_FO = (FW / 64) * (D / 32), I_AO = I_FO, I_OUT = (D / 64) * (D / 32), I_1 = (D / 64) * (DFF / 32), I_2 = (DFF / 64) * (D / 32);
    int r = it; const float* W; const float* g; bf16_t* WT; int N, ldo, co;
    if (r < I_IN) { W = p.w_in; g = p.g_mix; WT = (bf16_t*)(ws + WS_WIN); N = INW; ldo = D; co = 0; }
    else if ((r -= I_IN) < I_FO) { W = p.w_fo; g = nullptr; WT = (bf16_t*)(ws + WS_WFO); N = D; ldo = FW; co = 0; }
    else if ((r -= I_FO) < I_AO) { W = p.w_ao; g = nullptr; WT = (bf16_t*)(ws + WS_WAO); N = D; ldo = AW; co = 0; }
    else if ((r -= I_AO) < I_OUT) { W = p.w_out; g = nullptr; WT = (bf16_t*)(ws + WS_WOUT); N = D; ldo = D; co = 0; }
    else if ((r -= I_OUT) < I_1) { W = p.w1; g = p.g_mlp; WT = (bf16_t*)(ws + WS_W1); N = DFF; ldo = D; co = 0; }
    else if ((r -= I_1) < I_2) { W = p.w2; g = nullptr; WT = (bf16_t*)(ws + WS_W2); N = D; ldo = DFF; co = 0; }
    else return false;
    const int nblk = N / 32, kb = r / nblk, nb = r % nblk, k0 = 64 * kb, n0 = 32 * nb;
    w.src = W + (size_t)k0 * N + n0; w.gain = g ? g + k0 : nullptr; w.dst = WT + (size_t)n0 * ldo + co + k0; w.N = N; w.ldo = ldo; w.sc = (W == p.w_in && n0 >= 4096) ? -LOG2E : 1.f;
    return true;
}
__device__ __forceinline__ void p0_load(const WItem& w, f32x4 (&v)[8], float (&g)[8], int lane) {
#pragma unroll
    for (int j = 0; j < 8; ++j) { const int kk = (lane >> 3) + 8 * j; v[j] = *(const f32x4*)(w.src + (size_t)kk * w.N + (lane & 7) * 4); g[j] = (w.gain ? w.gain[kk] : 1.f) * w.sc; }
}
__device__ __forceinline__ void p0_process(const WItem& w, const f32x4 (&v)[8], const float (&g)[8], LAS float* scr, int lane) {
#pragma unroll
    for (int j = 0; j < 8; ++j) { const int kk = (lane >> 3) + 8 * j; LAS float* d = scr + kk * 33 + (lane & 7) * 4; const f32x4 x = v[j] * g[j]; d[0] = x[0]; d[1] = x[1]; d[2] = x[2]; d[3] = x[3]; }
    LDS_WAIT(); asm volatile("" ::: "memory");
    const int c = lane & 7;
#pragma unroll
    for (int j = 0; j < 4; ++j) { const int n = (lane >> 3) + 8 * j; const LAS float* s = scr + (8 * c) * 33 + n;
        u32x4 o; o.x = g8::cvt_pk_bf16(s[0 * 33], s[1 * 33]); o.y = g8::cvt_pk_bf16(s[2 * 33], s[3 * 33]); o.z = g8::cvt_pk_bf16(s[4 * 33], s[5 * 33]); o.w = g8::cvt_pk_bf16(s[6 * 33], s[7 * 33]);
        *(u32x4*)(w.dst + (size_t)n * w.ldo + 8 * c) = o; }
    LDS_WAIT(); asm volatile("" ::: "memory");
}
__device__ __forceinline__ void p0_xrow(const f32x4 (&v)[8], float* rstd1, bf16_t* XB, int m, int lane) {
    float s = 0.f;
#pragma unroll
    for (int j = 0; j < 8; ++j) s += (v[j].x * v[j].x + v[j].y * v[j].y) + (v[j].z * v[j].z + v[j].w * v[j].w);
    s = wave_sum(s);
    const float rs = rsqrtf(s * (1.f / D) + EPS);
    u32x2* o8 = (u32x2*)(XB + (size_t)m * D) + lane;
#pragma unroll
    for (int j = 0; j < 8; ++j) { u32x2 w; w.x = g8::cvt_pk_bf16(v[j].x * rs, v[j].y * rs); w.y = g8::cvt_pk_bf16(v[j].z * rs, v[j].w * rs); o8[64 * j] = w; }
}
__device__ __forceinline__ void p0_prologue(const Params& p, LAS unsigned char* lds, int gw, int NGW, int lane, int wave) {
    unsigned char* ws = p.ws;
    LAS float* scr = (LAS float*)(lds + wave * 16384);
    {
        WItem wa, wb; f32x4 va[8], vb[8]; float ga[8], gb[8];
        int it = gw; bool ha = p0_resolve(p, it, wa); if (ha) p0_load(wa, va, ga, lane);
        while (ha) {
            const bool hb = p0_resolve(p, it + NGW, wb); if (hb) p0_load(wb, vb, gb, lane);
            p0_process(wa, va, ga, scr, lane);
            if (!hb) break;
            it += 2 * NGW; ha = p0_resolve(p, it, wa); if (ha) p0_load(wa, va, ga, lane);
            p0_process(wb, vb, gb, scr, lane);
        }
    }
    XIn x{p.xp, p.xs}; float* rstd1 = (float*)(ws + T_RSTD1); bf16_t* XB = (bf16_t*)(ws + WS_XB);
    {
        f32x4 va[8], vb[8]; int m = gw;
        if (m < M) {
#pragma unroll
            for (int j = 0; j < 8; ++j) va[j] = ((const f32x4*)x.row(m) + lane)[64 * j]; }
        while (m < M) {
            const int m2 = m + NGW;
            if (m2 < M) {
#pragma unroll
                for (int j = 0; j < 8; ++j) vb[j] = ((const f32x4*)x.row(m2) + lane)[64 * j]; }
            p0_xrow(va, rstd1, XB, m, lane);
            if (m2 >= M) break;
            m = m2 + NGW;
            if (m < M) {
#pragma unroll
                for (int j = 0; j < 8; ++j) va[j] = ((const f32x4*)x.row(m) + lane)[64 * j]; }
            p0_xrow(vb, rstd1, XB, m2, lane);
        }
    }
    bf16_t* Tc = (bf16_t*)(ws + T_DFTC); bf16_t* Ts = (bf16_t*)(ws + T_DFTS);
    for (int i = gw * 64 + lane; i < 65536; i += NGW * 64) { const int a = ((i >> 8) * (i & 255)) & 255; const float ang = (float)a * (1.f / 128.f);
        Tc[i] = f2bf(cospif(ang) * S_ORTHO); Ts[i] = f2bf(sinpif(ang) * S_ORTHO); }
    { bf16_t* Tcs = (bf16_t*)(ws + T_CS);
      for (int i = gw * 64 + lane; i < 2 * 256 * 512; i += NGW * 64) { const int k = i & 511, n = (i >> 9) & 255, hh = i >> 17, cp = 128 * hh + (n & 127), a = (cp * (k & 255)) & 255; const float ang = (float)a * (1.f / 128.f);
          Tcs[i] = f2bf(k < 256 ? cospif(ang) * S_ORTHO : (n < 128 ? sinpif(ang) : -sinpif(ang)) * S_ORTHO); } }
    bf16_t* F128C = (bf16_t*)(ws + T_F128C); bf16_t* F128S = (bf16_t*)(ws + T_F128S); bf16_t* F64T = (bf16_t*)(ws + T_F64);
    for (int i = gw * 64 + lane; i < 16384; i += NGW * 64) { const int a = ((i >> 7) * (i & 127)) & 127; const float ang = (float)a * (1.f / 64.f);
        F128C[i] = f2bf(cospif(ang)); F128S[i] = f2bf(-sinpif(ang)); }
    for (int i = gw * 64 + lane; i < 3 * 64 * 72; i += NGW * 64) { const int tb = i / (64 * 72), k2 = (i / 72) % 64, sl = i % 72; float v = 0.f;
        if (sl < 64) { const int q4 = sl >> 4, hh = (sl >> 3) & 1, e = sl & 7, n2 = 16 * q4 + 8 * (e >> 2) + 4 * hh + (e & 3); const float ang = (float)((k2 * n2) & 63) * (1.f / 32.f);
            v = tb == 0 ? cospif(ang) : (tb == 1 ? sinpif(ang) : -sinpif(ang)); }
        F64T[i] = f2bf(v); }
    float* rp = (float*)(ws + T_RPB);
    for (int i = gw * 64 + lane; i < NH * 15 * 31; i += NGW * 64) rp[i] = p.rpb[i] * LOG2E;
}

template <int nM, int nN, int nt, int lda, int ldb> struct SchedGrid {
    static constexpr bool HAS_KEEP = false;
    const char* A; const char* B; int G, c;
    __device__ __forceinline__ bool next(int i, g8::Unit& u) const {
        const int L = i * G + c; if (L >= nM * nN) return false;
        int pm, pn; g8::tile_of<(nN <= 8 ? 8 : 4)>(L, nM, nN, pm, pn);
        u.pm = pm; u.pn = pn; u.nt = nt; u.keep = 0; u.br = 0;
        u.a = A + (size_t)pm * 256 * lda * 2; u.b = B + (size_t)pn * 256 * ldb * 2; return true;
    }
};
struct EpiChDft {
    bf16_t* Y;
    __device__ __forceinline__ void operator()(f32x4 (&acc)[2][2][4][2], const g8::Unit& u, int wr, int wc, int fr, int fq) const {
        if (u.keep) return;
        asm volatile("" : "+v"(fr), "+v"(fq));
        const int k0 = (u.pm & 15) * 256 + wr * 64 + fr;
        bf16_t* const Yb = Y + (size_t)(u.pm >> 4) * SEQ * FW + (u.pn * 128 + 32 * wc + 8 * fq);
#pragma unroll
        for (int ai = 0; ai < 2; ++ai)
#pragma unroll
            for (int m = 0; m < 4; ++m) { const int k = k0 + ai * 128 + m * 16;
#pragma unroll
                for (int bj = 0; bj < 2; ++bj) { const f32x4 v0 = acc[ai][bj][m][0], v1 = acc[ai][bj][m][1];
                    u32x4 w; w.x = g8::cvt_pk_bf16(v0[0], v0[1]); w.y = g8::cvt_pk_bf16(v0[2], v0[3]); w.z = g8::cvt_pk_bf16(v1[0], v1[1]); w.w = g8::cvt_pk_bf16(v1[2], v1[3]);
                    *(u32x4*)(Yb + (size_t)(bj ? ((SEQ - k) & (SEQ - 1)) : k) * FW) = w; } }
    }
};
struct EpiP1 {
    unsigned char* ws; bf16_t* gates; LAS unsigned char* xtra;
    __device__ __forceinline__ void operator()(f32x4 (&acc)[2][2][4][2], const g8::Unit& u, int wr, int wc, int fr, int fq) const {
        asm volatile("" : "+v"(fr), "+v"(fq));
        bf16_t* const Q = (bf16_t*)(ws + WS_Q); bf16_t* const Kb = (bf16_t*)(ws + WS_K); bf16_t* const V = (bf16_t*)(ws + WS_V); bf16_t* const FT = (bf16_t*)(ws + WS_FT); bf16_t* const SA = gates; bf16_t* const SB = gates + (size_t)M * D;
        const int pn = u.pn, row0 = u.pm * 256 + wr * 64 + fr;
        float rs[2][4];
#pragma unroll
        for (int ai = 0; ai < 2; ++ai)
#pragma unroll
            for (int m = 0; m < 4; ++m) rs[ai][m] = 1.f;
        if (pn < 8) {
            const bool isq = pn < 4; const LAS float* gn = (const LAS float*)(xtra + 16384) + (isq ? 0 : 64); bf16_t* O = isq ? Q : Kb; const int head = (pn & 3) * 4 + wc;
            f32x4 gv[2][2];
#pragma unroll
            for (int bj = 0; bj < 2; ++bj)
#pragma unroll
                for (int n = 0; n < 2; ++n) gv[bj][n] = *(const LAS f32x4*)(gn + 32 * bj + 8 * fq + 4 * n);
#pragma unroll
            for (int ai = 0; ai < 2; ++ai)
#pragma unroll
                for (int m = 0; m < 4; ++m) { const int r = row0 + ai * 128 + m * 16; const float rsv = rs[ai][m]; float ss = 0.f;
#pragma unroll
                    for (int bj = 0; bj < 2; ++bj)
#pragma unroll
                        for (int n = 0; n < 2; ++n) { const f32x4 v = acc[ai][bj][m][n]; ss += (v[0] * v[0] + v[1] * v[1]) + (v[2] * v[2] + v[3] * v[3]); }
                    ss = xsum32(xsum16(ss));
                    const float rn = rsqrtf(ss * rsv * rsv * (1.f / 64.f) + EPS) * rsv * (isq ? QSCALE : 1.f);
#pragma unroll
                    for (int bj = 0; bj < 2; ++bj) { const f32x4 v0 = acc[ai][bj][m][0] * rn * gv[bj][0], v1 = acc[ai][bj][m][1] * rn * gv[bj][1];
                        u32x4 w; w.x = g8::cvt_pk_bf16(v0[0], v0[1]); w.y = g8::cvt_pk_bf16(v0[2], v0[3]); w.z = g8::cvt_pk_bf16(v1[0], v1[1]); w.w = g8::cvt_pk_bf16(v1[2], v1[3]);
                        *(u32x4*)(O + (size_t)r * AW + head * 64 + 32 * bj + 8 * fq) = w; } }
        } else if (pn >= 12 && pn < 16) {
            const int b = (u.pm * 256) / SEQ; bf16_t* Fb = FT + ((size_t)b * FW + (pn - 12) * 256 + wr * 64 + fr) * SEQ + (u.pm * 256 - b * SEQ);
#pragma unroll
            for (int ai = 0; ai < 2; ++ai)
#pragma unroll
                for (int m = 0; m < 4; ++m) { bf16_t* rowp = Fb + (size_t)(ai * 128 + m * 16) * SEQ;
#pragma unroll
                    for (int bj = 0; bj < 2; ++bj) { const f32x4 v0 = acc[ai][bj][m][0], v1 = acc[ai][bj][m][1];
                        u32x4 w; w.x = g8::cvt_pk_bf16(v0[0], v0[1]); w.y = g8::cvt_pk_bf16(v0[2], v0[3]); w.z = g8::cvt_pk_bf16(v1[0], v1[1]); w.w = g8::cvt_pk_bf16(v1[2], v1[3]);
                        *(u32x4*)(rowp + g8::colbase<true>(bj, wc, fq)) = w; } }
        } else if (pn < 12) { store_rows<false>(acc, rs, V, AW, (pn - 8) * 256, row0, wc, fq);
        } else { store_rows<true>(acc, rs, pn < 24 ? SA : SB, D, ((pn - 16) & 7) * 256, row0, wc, fq); }
    }
    template <bool SIG> __device__ __forceinline__ void store_rows(const f32x4 (&acc)[2][2][4][2], const float (&rs)[2][4], bf16_t* O, int ldo, int cb, int row0, int wc, int fq) const {
#pragma unroll
        for (int ai = 0; ai < 2; ++ai)
#pragma unroll
            for (int m = 0; m < 4; ++m) { const int r = row0 + ai * 128 + m * 16; const float rsv = rs[ai][m];
#pragma unroll
                for (int bj = 0; bj < 2; ++bj) { f32x4 v0 = acc[ai][bj][m][0] * rsv, v1 = acc[ai][bj][m][1] * rsv;
                    if (SIG) {
#pragma unroll
                        for (int e = 0; e < 4; ++e) { v0[e] = __builtin_amdgcn_rcpf(1.f + __builtin_amdgcn_exp2f(v0[e])); v1[e] = __builtin_amdgcn_rcpf(1.f + __builtin_amdgcn_exp2f(v1[e])); } }
                    u32x4 w; w.x = g8::cvt_pk_bf16(v0[0], v0[1]); w.y = g8::cvt_pk_bf16(v0[2], v0[3]); w.z = g8::cvt_pk_bf16(v1[0], v1[1]); w.w = g8::cvt_pk_bf16(v1[2], v1[3]);
                    *(u32x4*)(O + (size_t)r * ldo + cb + g8::colbase<true>(bj, wc, fq)) = w; }
                __builtin_amdgcn_sched_barrier(0); }
    }
};

struct SchedP1 {
    static constexpr bool HAS_KEEP = false;
    const char* XB; const char* W; int G, c;
    __device__ __forceinline__ bool next(int i, g8::Unit& u) const {
        const int L = i * G + c; if (L >= (M / 256) * (INW / 256)) return false;
        int pm, pn; g8::tile_of<4>(L, M / 256, INW / 256, pm, pn);
        u.pm = pm; u.pn = pn; u.nt = D / 64; u.keep = 0; u.br = 0;
        const char* xa = XB + (size_t)pm * 256 * D * 2; const char* wb = W + (size_t)pn * 256 * D * 2; const bool sw = pn >= 12 && pn < 16;
        u.a = sw ? wb : xa; u.b = sw ? xa : wb; return true;
    }
};
struct SchedChDft {
    static constexpr bool HAS_KEEP = true;
    const char* PT; const char* TCS; int G, c;
    __device__ __forceinline__ bool next(int i, g8::Unit& u) const {
        const int L = (i >> 1) * G + c; if (L >= 48 * 8) return false;
        int pm, pn; g8::tile_of<8>(L, 48, 8, pm, pn); const int seg = i & 1, g = pn >> 1, h = pn & 1;
        u.pm = pm; u.pn = pn; u.nt = 4; u.keep = seg == 0; u.br = 0;
        u.a = PT + ((size_t)((pm >> 4) * 2 + seg) * FW + g * 256) * SEQ * 2 + (size_t)(pm & 15) * 256 * 2; u.b = TCS + (size_t)h * 256 * 512 * 2 + seg * 256 * 2; return true;
    }
};
struct SchedMerge2 {
    static constexpr bool HAS_KEEP = false;
    const char* Y; const char* ATT; const char* WFO; const char* WAO; int G, c;
    __device__ __forceinline__ bool next(int i, g8::Unit& u) const {
        const int L = (i >> 1) * G + c; if (L >= 96 * 8) return false;
        int pm, pn; g8::tile_of<8>(L, 96, 8, pm, pn); const int br = i & 1;
        u.pm = pm; u.pn = pn; u.nt = 16; u.keep = 0; u.br = br;
        u.a = (br ? ATT : Y) + (size_t)pm * 256 * 1024 * 2; u.b = (br ? WAO : WFO) + (size_t)pn * 256 * 1024 * 2; return true;
    }
};
__device__ __forceinline__ f32x4 bf_lo4(const u32x4 w, int half) { return half == 0 ? (f32x4){__uint_as_float(w[0] << 16), __uint_as_float(w[0] & 0xffff0000u), __uint_as_float(w[1] << 16), __uint_as_float(w[1] & 0xffff0000u)}
                                                                                       : (f32x4){__uint_as_float(w[2] << 16), __uint_as_float(w[2] & 0xffff0000u), __uint_as_float(w[3] << 16), __uint_as_float(w[3] & 0xffff0000u)}; }
__device__ __forceinline__ u32x4 pack8(const f32x4 v0, const f32x4 v1) { u32x4 w; w.x = g8::cvt_pk_bf16(v0[0], v0[1]); w.y = g8::cvt_pk_bf16(v0[2], v0[3]); w.z = g8::cvt_pk_bf16(v1[0], v1[1]); w.w = g8::cvt_pk_bf16(v1[2], v1[3]); return w; }
struct EpiMerge {
    unsigned char* ws; const bf16_t* gates;
    template <bool SECOND> __device__ __forceinline__ void run(f32x4 (&acc)[2][2][4][2], const g8::Unit& u, int wr, int wc, int fr, int fq) const {
        asm volatile("" : "+v"(fr), "+v"(fq));
        bf16_t* const MG = (bf16_t*)(ws + WS_MERGED); const bf16_t* const SA = gates; const bf16_t* const SB = gates + (size_t)M * D;
        const char* S = (const char*)(SECOND ? SB : SA); char* const MGb = (char*)MG;
        unsigned o0 = ((unsigned)(u.pm * 256 + wr * 64 + fr) * D + u.pn * 256 + g8::colbase<false>(0, wc, fq)) * 2u;
#define MRG_LD(d_, off_, base_) asm volatile("global_load_dwordx4 %0, %1, %2" : "=v"(d_) : "v"(off_), "s"(base_) : "memory")
#define MRG_OFF(ai_, m_, bj_) (o0 + (unsigned)((((ai_) * 128 + (m_) * 16) * D + (bj_) * 128) * 2))
        u32x4 ow[2][4][2];
        if constexpr (!SECOND) {
            u32x4 sg[2][4][2];
#pragma unroll
            for (int ai = 0; ai < 2; ++ai)
#pragma unroll
                for (int m = 0; m < 4; ++m)
#pragma unroll
                    for (int bj = 0; bj < 2; ++bj) { const unsigned o = MRG_OFF(ai, m, bj); MRG_LD(sg[ai][m][bj], o, S); }
#define MRG_ST0(ai_, m_, W_) do { asm volatile(W_ : "+v"(sg[ai_][m_][0]), "+v"(sg[ai_][m_][1]) :: "memory"); \
                _Pragma("unroll") for (int bj = 0; bj < 2; ++bj) ow[ai_][m_][bj] = pack8(bf_lo4(sg[ai_][m_][bj], 0) * acc[ai_][bj][m_][0], bf_lo4(sg[ai_][m_][bj], 1) * acc[ai_][bj][m_][1]); __builtin_amdgcn_sched_barrier(0); } while (0)
            MRG_ST0(0, 0, "s_waitcnt vmcnt(14)"); MRG_ST0(0, 1, "s_waitcnt vmcnt(12)"); MRG_ST0(0, 2, "s_waitcnt vmcnt(10)"); MRG_ST0(0, 3, "s_waitcnt vmcnt(8)");
            MRG_ST0(1, 0, "s_waitcnt vmcnt(6)"); MRG_ST0(1, 1, "s_waitcnt vmcnt(4)"); MRG_ST0(1, 2, "s_waitcnt vmcnt(2)"); MRG_ST0(1, 3, "s_waitcnt vmcnt(0)");
#undef MRG_ST0
        } else {
#pragma unroll
            for (int ai = 0; ai < 2; ++ai) {
                u32x4 sg[4][2], pv[4][2];
#pragma unroll
                for (int m = 0; m < 4; ++m)
#pragma unroll
                    for (int bj = 0; bj < 2; ++bj) { const unsigned o = MRG_OFF(ai, m, bj); MRG_LD(sg[m][bj], o, S); MRG_LD(pv[m][bj], o, MGb); }
#define MRG_ST1(m_, W_) do { asm volatile(W_ : "+v"(sg[m_][0]), "+v"(sg[m_][1]), "+v"(pv[m_][0]), "+v"(pv[m_][1]) :: "memory"); \
                _Pragma("unroll") for (int bj = 0; bj < 2; ++bj) ow[ai][m_][bj] = pack8(bf_lo4(sg[m_][bj], 0) * acc[ai][bj][m_][0] + bf_lo4(pv[m_][bj], 0), bf_lo4(sg[m_][bj], 1) * acc[ai][bj][m_][1] + bf_lo4(pv[m_][bj], 1)); __builtin_amdgcn_sched_barrier(0); } while (0)
                MRG_ST1(0, "s_waitcnt vmcnt(12)"); MRG_ST1(1, "s_waitcnt vmcnt(8)"); MRG_ST1(2, "s_waitcnt vmcnt(4)"); MRG_ST1(3, "s_waitcnt vmcnt(0)");
#undef MRG_ST1
            }
        }
#undef MRG_LD
#undef MRG_OFF
#pragma unroll
        for (int ai = 0; ai < 2; ++ai)
#pragma unroll
            for (int m = 0; m < 4; ++m)
#pragma unroll
                for (int bj = 0; bj < 2; ++bj) *(u32x4*)(MGb + (o0 + (unsigned)(((ai * 128 + m * 16) * D + bj * 128) * 2))) = ow[ai][m][bj];
    }
};
struct EpiMergeBr { EpiMerge e;
    __device__ __forceinline__ void operator()(f32x4 (&acc)[2][2][4][2], const g8::Unit& u, int wr, int wc, int fr, int fq) const { if (u.br) e.template run<true>(acc, u, wr, wc, fr, fq); else e.template run<false>(acc, u, wr, wc, fr, fq); } };
struct EpiX1 {
    XIn x; unsigned char* ws;
    __device__ __forceinline__ void operator()(f32x4 (&acc)[2][2][4][2], const g8::Unit& u, int wr, int wc, int fr, int fq) const {
        asm volatile("" : "+v"(fr), "+v"(fq));
        bf16_t* const X1B = (bf16_t*)(ws + WS_X1B); float* const SSQ = (float*)(ws + WS_SSQ);
        const int row0 = u.pm * 256 + wr * 64 + fr; const char* xbase = (const char*)((u.pm < SEQ / 256) ? x.xp : x.xs - (size_t)SEQ * D);
        const unsigned e0 = (unsigned)row0 * D + u.pn * 256 + g8::colbase<false>(0, wc, fq);
        u32x4 ow[2][4][2]; float ssr[2][4]; unsigned tok = 0;
#pragma unroll
        for (int ai = 0; ai < 2; ++ai) {
#pragma unroll
            for (int m = 0; m < 4; ++m) { const unsigned er = e0 + tok + (unsigned)((ai * 128 + m * 16) * D); float ss = 0.f;
#pragma unroll
                for (int bj = 0; bj < 2; ++bj) { const char* xr = xbase + (er + bj * 128) * 4u;
                    const f32x4 v0 = acc[ai][bj][m][0] + *(const f32x4*)xr, v1 = acc[ai][bj][m][1] + *(const f32x4*)(xr + 16);
                    ss += (v0[0] * v0[0] + v0[1] * v0[1]) + (v0[2] * v0[2] + v0[3] * v0[3]) + (v1[0] * v1[0] + v1[1] * v1[1]) + (v1[2] * v1[2] + v1[3] * v1[3]);
                    ow[ai][m][bj] = pack8(v0, v1); }
                if (m == 3) asm volatile("" : "+v"(tok), "+v"(ss));
                ssr[ai][m] = ss; } }
        asm volatile("" ::: "memory");
#pragma unroll
        for (int ai = 0; ai < 2; ++ai)
#pragma unroll
            for (int m = 0; m < 4; ++m) { const int r = row0 + ai * 128 + m * 16;
#pragma unroll
                for (int bj = 0; bj < 2; ++bj) *(u32x4*)((char*)X1B + (e0 + (unsigned)((ai * 128 + m * 16) * D + bj * 128)) * 2u) = ow[ai][m][bj];
                float ss = ssr[ai][m]; ss = xsum32(xsum16(ss));
                if (fq == 0) *(float*)((char*)SSQ + ((unsigned)r * 32u + u.pn * 4 + wc) * 4u) = ss; }
    }
};
__device__ __forceinline__ size_t tmp_base(int pm) { return pm < 48 ? WS_TMP0 : (WS_TMP1 - (size_t)48 * MiB); }
struct EpiTmp {
    unsigned char* ws;
    __device__ __forceinline__ void operator()(f32x4 (&acc)[2][2][4][2], const g8::Unit& u, int wr, int wc, int fr, int fq) const {
        asm volatile("" : "+v"(fr), "+v"(fq));
        const int row0 = u.pm * 256 + wr * 64 + fr; bf16_t* T = (bf16_t*)(ws + tmp_base(u.pm));
#pragma unroll
        for (int ai = 0; ai < 2; ++ai)
#pragma unroll
            for (int m = 0; m < 4; ++m) { bf16_t* rowp = T + (size_t)(row0 + ai * 128 + m * 16) * D + (u.pn * 256);
#pragma unroll
                for (int bj = 0; bj < 2; ++bj) { const f32x4 v0 = acc[ai][bj][m][0], v1 = acc[ai][bj][m][1];
                    u32x4 w; w.x = g8::cvt_pk_bf16(v0[0], v0[1]); w.y = g8::cvt_pk_bf16(v0[2], v0[3]); w.z = g8::cvt_pk_bf16(v1[0], v1[1]); w.w = g8::cvt_pk_bf16(v1[2], v1[3]);
                    *(u32x4*)(rowp + g8::colbase<false>(bj, wc, fq)) = w; } }
    }
};
struct EpiOut {
    float* out; const unsigned char* ws;
    __device__ __forceinline__ void operator()(f32x4 (&acc)[2][2][4][2], const g8::Unit& u, int wr, int wc, int fr, int fq) const {
        asm volatile("" : "+v"(fr), "+v"(fq));
        const bf16_t* const X1B = (const bf16_t*)(ws + WS_X1B); const float* const r2 = (const float*)(ws + T_RSTD2);
        const int row0 = u.pm * 256 + wr * 64 + fr; const bf16_t* T = (const bf16_t*)(ws + tmp_base(u.pm));
#pragma unroll
        for (int ai = 0; ai < 2; ++ai) {
#pragma unroll
            for (int m = 0; m < 4; ++m) { const int r = row0 + ai * 128 + m * 16; const float sc = r2[r]; const size_t ro = (size_t)r * D + (u.pn * 256);
#pragma unroll
                for (int bj = 0; bj < 2; ++bj) { const size_t o = ro + g8::colbase<false>(bj, wc, fq);
                    const u32x4 tv = *(const u32x4*)(T + o), xv = *(const u32x4*)(X1B + o);
                    const f32x4 r0 = bf_lo4(xv, 0) + (bf_lo4(tv, 0) + acc[ai][bj][m][0]) * sc, r1 = bf_lo4(xv, 1) + (bf_lo4(tv, 1) + acc[ai][bj][m][1]) * sc;
                    acc[ai][bj][m][0] = r0; acc[ai][bj][m][1] = r1; } }
            asm volatile("" ::: "memory"); }
#pragma unroll
        for (int ai = 0; ai < 2; ++ai)
#pragma unroll
            for (int m = 0; m < 4; ++m) { float* rowp = out + (size_t)(row0 + ai * 128 + m * 16) * D + (u.pn * 256);
#pragma unroll
                for (int bj = 0; bj < 2; ++bj) { const int cb = g8::colbase<false>(bj, wc, fq);
                    *(f32x4*)(rowp + cb) = acc[ai][bj][m][0]; *(f32x4*)(rowp + cb + 4) = acc[ai][bj][m][1]; } }
    }
};
__device__ __forceinline__ float relu_i(float x) { const int i = __builtin_bit_cast(int, x); return __builtin_bit_cast(float, i > 0 ? i : 0); }
struct EpiRelu2 {
    bf16_t* Ua; bf16_t* Ub;
    __device__ __forceinline__ void operator()(f32x4 (&acc)[2][2][4][2], const g8::Unit& u, int wr, int wc, int fr, int fq) const {
        asm volatile("" : "+v"(fr), "+v"(fq));
        const int row0 = u.pm * 256 + wr * 64 + fr; bf16_t* const U = (u.pn < 16) ? Ua : Ub; const int cb0 = (u.pn & 15) * 256;
#pragma unroll
        for (int ai = 0; ai < 2; ++ai)
#pragma unroll
            for (int m = 0; m < 4; ++m) { bf16_t* rowp = U + (size_t)(row0 + ai * 128 + m * 16) * 4096 + cb0;
#pragma unroll
                for (int bj = 0; bj < 2; ++bj) { f32x4 v0 = acc[ai][bj][m][0], v1 = acc[ai][bj][m][1];
#pragma unroll
                    for (int e = 0; e < 4; ++e) { const float a = relu_i(v0[e]), b = relu_i(v1[e]); v0[e] = a * a; v1[e] = b * b; }
                    u32x4 w; w.x = g8::cvt_pk_bf16(v0[0], v0[1]); w.y = g8::cvt_pk_bf16(v0[2], v0[3]); w.z = g8::cvt_pk_bf16(v1[0], v1[1]); w.w = g8::cvt_pk_bf16(v1[2], v1[3]);
                    *(u32x4*)(rowp + g8::colbase<false>(bj, wc, fq)) = w; } }
    }
};
struct SchedDown {
    static constexpr bool HAS_KEEP = true;
    const char* Ua; const char* Ub; const char* W2; int G, c;
    __device__ __forceinline__ bool next(int i, g8::Unit& u) const {
        const int L = (i >> 1) * G + c; if (L >= 96 * 8) return false;
        int pm, pn; g8::tile_of<4>(L, 96, 8, pm, pn); const int seg = i & 1;
        u.pm = pm; u.pn = pn; u.nt = 64; u.keep = seg == 0; u.br = 0;
        u.a = (seg ? Ua : Ub) + (size_t)pm * 256 * 4096 * 2; u.b = W2 + ((size_t)pn * 256 * DFF + (seg ? 0 : 4096)) * 2; return true;
    }
};
struct EpiDown {
    float* out; const unsigned char* ws; unsigned* pcnt;
    __device__ __forceinline__ void operator()(f32x4 (&acc)[2][2][4][2], const g8::Unit& u, int wr, int wc, int fr, int fq) const {
        const bool t0 = (wr == 0) && (wc == 0) && (fr == 0) && (fq == 0);
        unsigned* cnt = pcnt + 16 * u.pm;
        if (u.keep) {
            if (t0) __hip_atomic_fetch_add(cnt, 1u, __ATOMIC_RELAXED, __HIP_MEMORY_SCOPE_AGENT);
            return; }
        if (t0) { unsigned sp = 0; while (__hip_atomic_load(cnt, __ATOMIC_RELAXED, __HIP_MEMORY_SCOPE_AGENT) < 8u && ++sp < (1u << 16)) __builtin_amdgcn_s_sleep(2); }
        __builtin_amdgcn_s_barrier();
        asm volatile("" : "+v"(fr), "+v"(fq));
        const bf16_t* const X1B = (const bf16_t*)(ws + WS_X1B); const float* const r2 = (const float*)(ws + T_RSTD2);
        const int row0 = u.pm * 256 + wr * 64 + fr;
        const unsigned e0 = (unsigned)row0 * D + u.pn * 256 + g8::colbase<false>(0, wc, fq);
#pragma unroll
        for (int ai = 0; ai < 2; ++ai) {
            u32x4 xv[4][2]; float scv[4];
#pragma unroll
            for (int m = 0; m < 4; ++m) { const float sc = *(const float*)((const char*)r2 + (unsigned)(row0 + ai * 128 + m * 16) * 4u);
#pragma unroll
                for (int bj = 0; bj < 2; ++bj) xv[m][bj] = *(const u32x4*)((const char*)X1B + (e0 + (unsigned)((ai * 128 + m * 16) * D + bj * 128)) * 2u);
                scv[m] = sc; }
            asm volatile("" : "+v"(xv[0][0]), "+v"(xv[0][1]), "+v"(xv[1][0]), "+v"(xv[1][1]), "+v"(xv[2][0]), "+v"(xv[2][1]), "+v"(xv[3][0]), "+v"(xv[3][1]));
#pragma unroll
            for (int m = 0; m < 4; ++m) {
#pragma unroll
                for (int bj = 0; bj < 2; ++bj) { char* op = (char*)out + (e0 + (unsigned)((ai * 128 + m * 16) * D + bj * 128)) * 4u;
                    const f32x4 r0 = bf_lo4(xv[m][bj], 0) + acc[ai][bj][m][0] * scv[m], r1 = bf_lo4(xv[m][bj], 1) + acc[ai][bj][m][1] * scv[m];
                    *(f32x4*)op = r0; *(f32x4*)(op + 16) = r1; }
                __builtin_amdgcn_sched_barrier(0); }
            asm volatile("" ::: "memory"); }
    }
};
typedef short v4i16_t __attribute__((ext_vector_type(4)));
__device__ __forceinline__ void natten_phase(const Params& p, LAS unsigned char* lds, int G, int bx, int tid, int lane, int wave) {
    unsigned char* ws = p.ws;
    const bf16_t* Qg = (const bf16_t*)(ws + WS_Q); const bf16_t* Kg = (const bf16_t*)(ws + WS_K); const bf16_t* Vg = (const bf16_t*)(ws + WS_V); bf16_t* ATT = (bf16_t*)(ws + WS_ATT);
    const float* rp = (const float*)(ws + T_RPB);
    LAS float* biasT = (LAS float*)(lds + XTRA_OFF);
    const int j = lane & 15, q = lane >> 4, qq = j >> 2, pp = j & 3;
    constexpr int QOFF = XTRA_OFF + 4096;
    const int wv = __builtin_amdgcn_readfirstlane(wave);
    const int keyl = (wv & 3) * 8 + (lane >> 3), pch = lane & 7;
    const unsigned voK = (unsigned)(keyl * AW + ((pch ^ ((keyl >> 1) & 7)) << 3)) * 2u, voV = (unsigned)(keyl * AW + ((pch ^ (2 * ((keyl >> 1) & 3))) << 3)) * 2u;
    const unsigned voQ = (unsigned)((lane >> 3) * AW + pch * 8) * 2u, voB = (unsigned)lane * 4u;
#define NAT_PIECE(sb_expr_, vo_, ldsoff_, sz_) do { const char* sb_ = (sb_expr_); asm volatile("" : "+s"(sb_)); unsigned vv_ = (vo_); asm volatile("" : "+v"(vv_)); \
        __builtin_amdgcn_global_load_lds((const unsigned*)(sb_ + vv_), (LAS unsigned*)(lds + (ldsoff_)), sz_, 0, 0); } while (0)
#define NAT_DMA_KV(it2_, gbase_, ldsoff_, vo_) do { const int g2 = (it2_) & 3, rb2 = ((it2_) >> 2) & 15, h2 = ((it2_) >> 6) & 15, b2 = (it2_) >> 10; \
        const int base2 = min(max(8 * rb2 - 4, 0), 112), kcb2 = (g2 == 0) ? 0 : (g2 == 1) ? 8 : (g2 == 2) ? 24 : 32; \
        const char* sb0_ = (const char*)(gbase_) + (size_t)((((unsigned)b2 * SEQ + (base2 + (wv >> 2)) * 64 + kcb2) * AW + h2 * HD) * 2u); \
        _Pragma("unroll") for (int jj = 0; jj < 8; ++jj) NAT_PIECE(sb0_ + jj * 262144, vo_, (ldsoff_) + 8192 * jj + 1024 * wv, 16); } while (0)
#define NAT_DMA_QB(it2_) do { const int g2 = (it2_) & 3, rb2 = ((it2_) >> 2) & 15, h2 = ((it2_) >> 6) & 15, b2 = (it2_) >> 10; \
        const char* sq_ = (const char*)Qg + (size_t)((((unsigned)b2 * SEQ + (8 * rb2 + wv) * 64 + 16 * g2) * AW + h2 * HD) * 2u); \
        NAT_PIECE(sq_, voQ, QOFF + 2048 * wv, 16); NAT_PIECE(sq_ + 8 * AW * 2, voQ, QOFF + 2048 * wv + 1024, 16); \
        NAT_PIECE((const char*)rp + (size_t)((h2 * 465 + 64 * wv) * 4), voB, XTRA_OFF + 256 + 256 * wv, 4); } while (0)
    if (bx < 3072) { NAT_DMA_QB(bx); NAT_DMA_KV(bx, Kg, 0, voK); asm volatile("s_waitcnt vmcnt(0)" ::: "memory"); NAT_DMA_KV(bx, Vg, 65536, voV); }
    for (int it = bx; it < 3072; it += G) {
        const int g = it & 3, rb = (it >> 2) & 15, h = (it >> 6) & 15, b = it >> 10;
        const int base = min(max(8 * rb - 4, 0), 112), kcb = (g == 0) ? 0 : (g == 1) ? 8 : (g == 2) ? 24 : 32;
        const int itn = (it + G < 3072) ? it + G : it;
        asm volatile("s_waitcnt vmcnt(10)" ::: "memory");
        __builtin_amdgcn_s_barrier(); asm volatile("" ::: "memory");
        const int r = 8 * rb + wave, rs = min(max(r - 4, 0), 120), s0 = rs - base, c = 16 * g + j, cs = min(max(c - 8, 0), 48);
        bool sel[4]; int bix[4];
#pragma unroll
        for (int e = 0; e < 4; ++e) { const int kc0 = kcb + 4 * q + e; sel[e] = kc0 >= cs; bix[e] = 64 + (rs - r + 7) * 31 + 15 - c + kc0 + (sel[e] ? 0 : 16); }
        const unsigned m01 = (sel[0] ? 0xFFFFu : 0u) | (sel[1] ? 0xFFFF0000u : 0u), m23 = (sel[2] ? 0xFFFFu : 0u) | (sel[3] ? 0xFFFF0000u : 0u);
#define NAT_RD128(d_, a_, off_) asm volatile("ds_read_b128 %0, %1 offset:%2" : "=v"(d_) : "v"(a_), "n"(off_) : "memory")
#define NAT_RD32(d_, a_, off_) asm volatile("ds_read_b32 %0, %1 offset:%2" : "=v"(d_) : "v"(a_), "n"(off_) : "memory")
        const unsigned lb_ = (unsigned)(size_t)lds;
        unsigned kb_[2][2], bb_[4];
#pragma unroll
        for (int hf = 0; hf < 2; ++hf) { const int key = 16 * hf + j, ka = (s0 * 32 + key) * 128, sw = (key >> 1) & 7; kb_[hf][0] = lb_ + ka + ((q ^ sw) << 4); kb_[hf][1] = lb_ + ka + (((4 + q) ^ sw) << 4); }
#pragma unroll
        for (int e = 0; e < 4; ++e) bb_[e] = lb_ + XTRA_OFF + 4 * bix[e];
        bf16x8 qf0, qf1; { const unsigned qa_ = lb_ + QOFF + 2048 * wv + j * 128 + q * 16; NAT_RD128(qf0, qa_, 0); NAT_RD128(qf1, qa_, 64); }
        f32x4 S[8][2];
        bf16x8 kf[2][2][2]; float bz[2][4];
#define NAT_READS(bf_, a_) do { \
            NAT_RD128(kf[bf_][0][0], kb_[0][0], (a_) * 4096); NAT_RD128(kf[bf_][0][1], kb_[0][1], (a_) * 4096); NAT_RD128(kf[bf_][1][0], kb_[1][0], (a_) * 4096); NAT_RD128(kf[bf_][1][1], kb_[1][1], (a_) * 4096); \
            NAT_RD32(bz[bf_][0], bb_[0], (a_) * 124); NAT_RD32(bz[bf_][1], bb_[1], (a_) * 124); NAT_RD32(bz[bf_][2], bb_[2], (a_) * 124); NAT_RD32(bz[bf_][3], bb_[3], (a_) * 124); } while (0)
#define NAT_SCORE(bf_, a_, WAITSTR_) do { \
            asm volatile(WAITSTR_ : "+v"(kf[bf_][0][0]), "+v"(kf[bf_][0][1]), "+v"(kf[bf_][1][0]), "+v"(kf[bf_][1][1]), "+v"(bz[bf_][0]), "+v"(bz[bf_][1]), "+v"(bz[bf_][2]), "+v"(bz[bf_][3]), "+v"(qf0), "+v"(qf1) :: "memory"); \
            { const f32x4 bzv = {bz[bf_][0], bz[bf_][1], bz[bf_][2], bz[bf_][3]}; \
                _Pragma("unroll") for (int hf = 0; hf < 2; ++hf) { f32x4 z = __builtin_amdgcn_mfma_f32_16x16x32_bf16(kf[bf_][hf][0], qf0, bzv, 0, 0, 0); \
                    S[a_][hf] = __builtin_amdgcn_mfma_f32_16x16x32_bf16(kf[bf_][hf][1], qf1, z, 0, 0, 0); } } } while (0)
        NAT_READS(0, 0);
        NAT_READS(1, 1); NAT_SCORE(0, 0, "s_waitcnt lgkmcnt(8)"); NAT_READS(0, 2); NAT_SCORE(1, 1, "s_waitcnt lgkmcnt(8)"); NAT_READS(1, 3); NAT_SCORE(0, 2, "s_waitcnt lgkmcnt(8)");
        NAT_READS(0, 4); NAT_SCORE(1, 3, "s_waitcnt lgkmcnt(8)"); NAT_READS(1, 5); NAT_SCORE(0, 4, "s_waitcnt lgkmcnt(8)"); NAT_READS(0, 6); NAT_SCORE(1, 5, "s_waitcnt lgkmcnt(8)");
        NAT_READS(1, 7); NAT_SCORE(0, 6, "s_waitcnt lgkmcnt(8)"); NAT_SCORE(1, 7, "s_waitcnt lgkmcnt(0)");
#undef NAT_READS
#undef NAT_SCORE
#undef NAT_RD128
#undef NAT_RD32
        asm volatile("s_waitcnt vmcnt(0)" ::: "memory");
        __builtin_amdgcn_s_barrier(); asm volatile("" ::: "memory");
        NAT_DMA_QB(itn); NAT_DMA_KV(itn, Kg, 0, voK);
        f32x4 Sf[8]; float mx = -INFINITY;
#pragma unroll
        for (int a = 0; a < 8; ++a)
#pragma unroll
            for (int e = 0; e < 4; ++e) { const float sv = sel[e] ? S[a][0][e] : S[a][1][e]; Sf[a][e] = sv; mx = fmaxf(mx, sv); }
        mx = xmax32(xmax16(mx));
        float l = 0.f;
#pragma unroll
        for (int a = 0; a < 8; ++a)
#pragma unroll
            for (int e = 0; e < 4; ++e) { const float pv = __builtin_amdgcn_exp2f(Sf[a][e] - mx); Sf[a][e] = pv; l += pv; }
        l = xsum32(xsum16(l));
        f32x4 O[4];
#pragma unroll
        for (int dt = 0; dt < 4; ++dt) O[dt] = (f32x4){0.f, 0.f, 0.f, 0.f};
        unsigned vb_[4][2];
#pragma unroll
        for (int dt = 0; dt < 4; ++dt) { const int kk0 = 4 * q + qq, kk1 = 16 + 4 * q + qq, chunk = 2 * dt + (pp >> 1);
            vb_[dt][0] = (unsigned)(size_t)lds + 65536 + (s0 * 32 + kk0) * 128 + ((chunk ^ (2 * ((kk0 >> 1) & 3))) << 4) + (pp & 1) * 8;
            vb_[dt][1] = (unsigned)(size_t)lds + 65536 + (s0 * 32 + kk1) * 128 + ((chunk ^ (2 * ((kk1 >> 1) & 3))) << 4) + (pp & 1) * 8; }
        asm volatile("" : "+v"(vb_[0][0]), "+v"(vb_[0][1]), "+v"(vb_[1][0]), "+v"(vb_[1][1]), "+v"(vb_[2][0]), "+v"(vb_[2][1]), "+v"(vb_[3][0]), "+v"(vb_[3][1]));
#define NAT_TR(d_, a_, off_) asm volatile("ds_read_b64_tr_b16 %0, %1 offset:%2" : "=v"(d_) : "v"(a_), "n"(off_) : "memory")
        v4i16_t lo[2][4], hi[2][4];
#define NAT_READV(bf_, a_) do { NAT_TR(lo[bf_][0], vb_[0][0], (a_) * 4096); NAT_TR(hi[bf_][0], vb_[0][1], (a_) * 4096); NAT_TR(lo[bf_][1], vb_[1][0], (a_) * 4096); NAT_TR(hi[bf_][1], vb_[1][1], (a_) * 4096); \
            NAT_TR(lo[bf_][2], vb_[2][0], (a_) * 4096); NAT_TR(hi[bf_][2], vb_[2][1], (a_) * 4096); NAT_TR(lo[bf_][3], vb_[3][0], (a_) * 4096); NAT_TR(hi[bf_][3], vb_[3][1], (a_) * 4096); } while (0)
#define NAT_PV_ROW(a_, bf_, WAITSTR_) do { const unsigned p01 = g8::cvt_pk_bf16(Sf[a_][0], Sf[a_][1]), p23 = g8::cvt_pk_bf16(Sf[a_][2], Sf[a_][3]); \
            u32x4 pw; pw.x = p01 & m01; pw.y = p23 & m23; pw.z = p01 & ~m01; pw.w = p23 & ~m23; const bf16x8 pf = __builtin_bit_cast(bf16x8, pw); \
            asm volatile(WAITSTR_ : "+v"(lo[bf_][0]), "+v"(hi[bf_][0]), "+v"(lo[bf_][1]), "+v"(hi[bf_][1]), "+v"(lo[bf_][2]), "+v"(hi[bf_][2]), "+v"(lo[bf_][3]), "+v"(hi[bf_][3]) :: "memory"); \
            _Pragma("unroll") for (int dt = 0; dt < 4; ++dt) { const bf16x8 vf = (bf16x8){lo[bf_][dt][0], lo[bf_][dt][1], lo[bf_][dt][2], lo[bf_][dt][3], hi[bf_][dt][0], hi[bf_][dt][1], hi[bf_][dt][2], hi[bf_][dt][3]}; \
                O[dt] = __builtin_amdgcn_mfma_f32_16x16x32_bf16(vf, pf, O[dt], 0, 0, 0); } } while (0)
        NAT_READV(0, 0);
        NAT_READV(1, 1); NAT_PV_ROW(0, 0, "s_waitcnt lgkmcnt(8)"); NAT_READV(0, 2); NAT_PV_ROW(1, 1, "s_waitcnt lgkmcnt(8)"); NAT_READV(1, 3); NAT_PV_ROW(2, 0, "s_waitcnt lgkmcnt(8)");
        NAT_READV(0, 4); NAT_PV_ROW(3, 1, "s_waitcnt lgkmcnt(8)"); NAT_READV(1, 5); NAT_PV_ROW(4, 0, "s_waitcnt lgkmcnt(8)"); NAT_READV(0, 6); NAT_PV_ROW(5, 1, "s_waitcnt lgkmcnt(8)");
        NAT_READV(1, 7); NAT_PV_ROW(6, 0, "s_waitcnt lgkmcnt(8)"); NAT_PV_ROW(7, 1, "s_waitcnt lgkmcnt(0)");
#undef NAT_READV
#undef NAT_PV_ROW
#undef NAT_TR
        asm volatile("" ::: "memory"); __builtin_amdgcn_s_barrier(); asm volatile("" ::: "memory");
        const float il = __builtin_amdgcn_rcpf(l);
        bf16_t* op = ATT + ((size_t)b * SEQ + r * 64 + c) * ATT_LD + h * HD + 4 * q + ((q & 1) ? 12 : 0);
#pragma unroll
        for (int pr2 = 0; pr2 < 2; ++pr2) { const f32x4 o0 = O[2 * pr2] * il, o1 = O[2 * pr2 + 1] * il;
            const auto rx = __builtin_amdgcn_permlane16_swap(g8::cvt_pk_bf16(o0[0], o0[1]), g8::cvt_pk_bf16(o1[0], o1[1]), false, false);
            const auto ry = __builtin_amdgcn_permlane16_swap(g8::cvt_pk_bf16(o0[2], o0[3]), g8::cvt_pk_bf16(o1[2], o1[3]), false, false);
            u32x4 w; w.x = rx[0]; w.y = ry[0]; w.z = rx[1]; w.w = ry[1]; *(u32x4*)(op + 32 * pr2) = w; }
        NAT_DMA_KV(itn, Vg, 65536, voV);
    }
#undef NAT_DMA_KV
#undef NAT_DMA_QB
#undef NAT_PIECE
    asm volatile("s_waitcnt vmcnt(0)" ::: "memory");
    __syncthreads();
}

__device__ __forceinline__ int crow32(int g, int h) { return (g & 3) + 8 * (g >> 2) + 4 * h; }
__device__ __forceinline__ void fft_phase(const Params& p, LAS unsigned char* lds, int G, int bx, int tid, int lane, int wave) {
    unsigned char* ws = p.ws;
    const bf16_t* FT = (const bf16_t*)(ws + WS_FT); bf16_t* PT = (bf16_t*)(ws + WS_PT);
    const int r = lane & 31, h = lane >> 5, kb = wave & 3, chw = wave >> 2, li = lane & 15, qq = li >> 2, pp = li & 3, colhalf = (lane >> 4) & 1;
    LAS unsigned char* tbl = lds + XTRA_OFF + 4096;
    for (int i = tid; i < 27648 / 16; i += NTHR) *(LAS u32x4*)(tbl + 16 * i) = *(const u32x4*)(ws + T_F64 + 16 * i);
    bf16x8 Bc[8], Bs[8];
    { const bf16_t* fc = (const bf16_t*)(ws + T_F128C) + (32 * kb + r) * 128 + 8 * h; const bf16_t* fs = (const bf16_t*)(ws + T_F128S) + (32 * kb + r) * 128 + 8 * h;
#pragma unroll
      for (int ks = 0; ks < 8; ++ks) { Bc[ks] = *(const bf16x8*)(fc + 16 * ks); Bs[ks] = *(const bf16x8*)(fs + 16 * ks); } }
    unsigned twp[2][16];
#pragma unroll
    for (int mt = 0; mt < 2; ++mt)
#pragma unroll
        for (int g = 0; g < 16; ++g) { const int n2 = 32 * mt + crow32(g, h), k1 = 32 * kb + r; const float x = (float)((n2 * k1) & 8191) * (1.f / 8192.f); twp[mt][g] = g8::cvt_pk_bf16(__builtin_amdgcn_cosf(x), __builtin_amdgcn_sinf(x)); }
    __syncthreads();
    const int sw = ((qq >> 1) & 1) << 2;
    u32x4 v[4];
    auto issue = [&](int it2) { const bf16_t* src2 = FT + ((size_t)((it2 / 512) * FW + 2 * (it2 % 512))) * SEQ;
#pragma unroll
        for (int jj = 0; jj < 4; ++jj) v[jj] = *(const u32x4*)(src2 + (size_t)(tid + NTHR * jj) * 8); };
    if (bx < 1536) issue(bx);
    for (int it = bx; it < 1536; it += G) {
        const int b = it / 512, cp = it % 512, ch = 2 * cp + chw;
        __syncthreads();
#pragma unroll
        for (int jj = 0; jj < 4; ++jj) { const int pid = tid + NTHR * jj, chn = pid >> 10, n1 = (pid >> 3) & 127, c8 = pid & 7;
            *(LAS u32x4*)(lds + chn * 16384 + n1 * 128 + ((c8 ^ (((n1 >> 1) & 1) << 2)) << 4)) = v[jj]; }
        __syncthreads();
        if (it + G < 1536) issue(it + G);
        int frep_ = FFT_REP; asm volatile("" : "+s"(frep_));
        for (int rep_ = 0; rep_ < frep_; ++rep_) {
        f32x16 a1r[2], a1i[2];
#pragma unroll
        for (int mt = 0; mt < 2; ++mt)
#pragma unroll
            for (int g = 0; g < 16; ++g) { a1r[mt][g] = 0.f; a1i[mt][g] = 0.f; }
        {
            unsigned fa_[2];
#pragma unroll
            for (int mt = 0; mt < 2; ++mt) { const int c8 = 4 * mt + 2 * colhalf + (pp >> 1); fa_[mt] = (unsigned)(size_t)lds + chw * 16384 + (8 * h + qq) * 128 + ((c8 ^ sw) << 4) + (pp & 1) * 8; }
            v4i16_t lo[3][2], hi[3][2];
#define FFT_TR(d_, a_, off_) asm volatile("ds_read_b64_tr_b16 %0, %1 offset:%2" : "=v"(d_) : "v"(a_), "n"(off_) : "memory")
#define FFT_RD1(bf_, ks_) do { FFT_TR(lo[bf_][0], fa_[0], (ks_) * 2048); FFT_TR(hi[bf_][0], fa_[0], (ks_) * 2048 + 512); FFT_TR(lo[bf_][1], fa_[1], (ks_) * 2048); FFT_TR(hi[bf_][1], fa_[1], (ks_) * 2048 + 512); } while (0)
#define FFT_ST1(bf_, ks_, WAITSTR_) do { asm volatile(WAITSTR_ : "+v"(lo[bf_][0]), "+v"(hi[bf_][0]), "+v"(lo[bf_][1]), "+v"(hi[bf_][1]) :: "memory"); \
                _Pragma("unroll") for (int mt = 0; mt < 2; ++mt) { const bf16x8 A = (bf16x8){lo[bf_][mt][0], lo[bf_][mt][1], lo[bf_][mt][2], lo[bf_][mt][3], hi[bf_][mt][0], hi[bf_][mt][1], hi[bf_][mt][2], hi[bf_][mt][3]}; \
                    a1r[mt] = __builtin_amdgcn_mfma_f32_32x32x16_bf16(A, Bc[ks_], a1r[mt], 0, 0, 0); a1i[mt] = __builtin_amdgcn_mfma_f32_32x32x16_bf16(A, Bs[ks_], a1i[mt], 0, 0, 0); } } while (0)
            FFT_RD1(0, 0); FFT_RD1(1, 1);
            FFT_RD1(2, 2); FFT_ST1(0, 0, "s_waitcnt lgkmcnt(8)"); FFT_RD1(0, 3); FFT_ST1(1, 1, "s_waitcnt lgkmcnt(8)"); FFT_RD1(1, 4); FFT_ST1(2, 2, "s_waitcnt lgkmcnt(8)");
            FFT_RD1(2, 5); FFT_ST1(0, 3, "s_waitcnt lgkmcnt(8)"); FFT_RD1(0, 6); FFT_ST1(1, 4, "s_waitcnt lgkmcnt(8)"); FFT_RD1(1, 7); FFT_ST1(2, 5, "s_waitcnt lgkmcnt(8)");
            FFT_ST1(0, 6, "s_waitcnt lgkmcnt(4)"); FFT_ST1(1, 7, "s_waitcnt lgkmcnt(0)");
#undef FFT_ST1
#undef FFT_RD1
#undef FFT_TR
        }
        if (kb == 0) {
            float sg = 0.f;
#pragma unroll
            for (int mt = 0; mt < 2; ++mt)
#pragma unroll
                for (int g = 0; g < 16; ++g) sg += (g & 1) ? -a1r[mt][g] : a1r[mt][g];
            sg = xsum32(sg);
            if (lane == 0) ((float*)(ws + T_P4096))[b * FW + ch] = sg;
        }
        bf16x8 Br[2][2], Bi[2][2];
#pragma unroll
        for (int mt = 0; mt < 2; ++mt)
#pragma unroll
            for (int s = 0; s < 2; ++s) { u32x4 wr_, wi_;
#pragma unroll
                for (int e2 = 0; e2 < 4; ++e2) { const int g0 = 8 * s + 2 * e2, g1 = g0 + 1;
                    unsigned w0 = twp[mt][g0], w1 = twp[mt][g1]; asm volatile("" : "+v"(w0), "+v"(w1));
                    const float c0 = __uint_as_float(w0 << 16), s0_ = __uint_as_float(w0 & 0xffff0000u), c1 = __uint_as_float(w1 << 16), s1_ = __uint_as_float(w1 & 0xffff0000u);
                    const float xr0 = a1r[mt][g0] * c0 + a1i[mt][g0] * s0_, xi0 = a1i[mt][g0] * c0 - a1r[mt][g0] * s0_;
                    const float xr1 = a1r[mt][g1] * c1 + a1i[mt][g1] * s1_, xi1 = a1i[mt][g1] * c1 - a1r[mt][g1] * s1_;
                    wr_[e2] = g8::cvt_pk_bf16(xr0, xr1); wi_[e2] = g8::cvt_pk_bf16(xi0, xi1); }
                Br[mt][s] = __builtin_bit_cast(bf16x8, wr_); Bi[mt][s] = __builtin_bit_cast(bf16x8, wi_); }
        LAS unsigned char* stg = lds + 65536 + wave * 8192;
#pragma unroll
        for (int mt2 = 0; mt2 < 1; ++mt2) {
            f32x16 pr, pi;
#pragma unroll
            for (int g = 0; g < 16; ++g) { pr[g] = 0.f; pi[g] = 0.f; }
#pragma unroll
            for (int q4 = 0; q4 < 4; ++q4) { const int off = (32 * mt2 + r) * 144 + (q4 * 16 + 8 * h) * 2;
                bf16x8 Cf = *(const LAS bf16x8*)(tbl + off), Sf = *(const LAS bf16x8*)(tbl + 9216 + off), NSf = *(const LAS bf16x8*)(tbl + 18432 + off);
                asm volatile("" : "+v"(Cf), "+v"(Sf), "+v"(NSf));
                pr = __builtin_amdgcn_mfma_f32_32x32x16_bf16(Cf, Br[q4 >> 1][q4 & 1], pr, 0, 0, 0);
                pr = __builtin_amdgcn_mfma_f32_32x32x16_bf16(Sf, Bi[q4 >> 1][q4 & 1], pr, 0, 0, 0);
                pi = __builtin_amdgcn_mfma_f32_32x32x16_bf16(Cf, Bi[q4 >> 1][q4 & 1], pi, 0, 0, 0);
                pi = __builtin_amdgcn_mfma_f32_32x32x16_bf16(NSf, Br[q4 >> 1][q4 & 1], pi, 0, 0, 0); }
#pragma unroll
            for (int g = 0; g < 16; ++g) { const int row = 32 * mt2 + crow32(g, h);
                *(LAS bf16_t*)(stg + row * 64 + r * 2) = (bf16_t)(g8::cvt_pk_bf16(pr[g], pr[g]) & 0xffffu);
                *(LAS bf16_t*)(stg + 4096 + row * 64 + r * 2) = (bf16_t)(g8::cvt_pk_bf16(pi[g], pi[g]) & 0xffffu); }
        }
#pragma unroll
        for (int part = 0; part < 2; ++part)
#pragma unroll
            for (int st = 0; st < 2; ++st) { const int row = st * 16 + (lane >> 2), c4 = lane & 3;
                const u32x4 w = *(const LAS u32x4*)(stg + part * 4096 + row * 64 + c4 * 16);
                *(u32x4*)(PT + ((size_t)((b * 2 + part) * FW + ch)) * SEQ + 128 * row + 32 * kb + 8 * c4) = w; }
        }
    }
    __syncthreads();
}
__device__ __forceinline__ void ph_inproj(const Params& p, LAS unsigned char* lds, int G, int bx) {
    unsigned char* ws = p.ws;
    { typedef SchedP1 SG; SG S{(const char*)(ws + WS_XB), (const char*)(ws + WS_WIN), G, bx};
      if (threadIdx.x < 128) ((LAS float*)(lds + XTRA_OFF + 16384))[threadIdx.x] = threadIdx.x < 64 ? p.q_norm[threadIdx.x] : p.k_norm[threadIdx.x - 64];
      __syncthreads();
      EpiP1 E{ws, (bf16_t*)p.out, lds + XTRA_OFF};
      g8::gemm_phase<EpiP1, SG, D, D, true, KREP_[1]>(lds, S, E); }
}
__device__ __forceinline__ void ph_chdft(const Params& p, LAS unsigned char* lds, int G, int bx, int tid) {
    unsigned char* ws = p.ws;
    if (bx >= 244) {
        const int j = bx - 244, b = j >> 2, g = j & 3, c8 = tid & 31, cr = tid >> 5;
        const float* P4 = (const float*)(ws + T_P4096) + b * FW + g * 256 + cr * 16; const bf16_t* Tc = (const bf16_t*)(ws + T_DFTC) + (size_t)cr * 16 * 256 + 8 * c8;
        f32x4 s0 = {0.f, 0.f, 0.f, 0.f}, s1 = {0.f, 0.f, 0.f, 0.f};
#pragma unroll
        for (int q = 0; q < 16; ++q) { const float pv = P4[q]; const u32x4 w = *(const u32x4*)(Tc + q * 256); s0 += pv * bf_lo4(w, 0); s1 += pv * bf_lo4(w, 1); }
        LAS float* red = (LAS float*)lds;
        *(LAS f32x4*)(red + cr * 256 + 8 * c8) = s0; *(LAS f32x4*)(red + cr * 256 + 8 * c8 + 4) = s1;
        __syncthreads();
        if (tid < 256) { float t = 0.f;
#pragma unroll
            for (int q = 0; q < 16; ++q) t += red[q * 256 + tid];
            ((bf16_t*)(ws + WS_Y))[((size_t)b * SEQ + 4096) * FW + g * 256 + tid] = f2bf(t); }
        __syncthreads();
    }
    SchedChDft S{(const char*)(ws + WS_PT), (const char*)(ws + T_CS), G, bx};
    EpiChDft E{(bf16_t*)(ws + WS_Y)};
    g8::gemm_phase<EpiChDft, SchedChDft, SEQ, 512, false, 1, true>(lds, S, E);
}
__device__ __forceinline__ void ph_merge(const Params& p, LAS unsigned char* lds, int G, int bx) {
    unsigned char* ws = p.ws;
    SchedMerge2 S{(const char*)(ws + WS_Y), (const char*)(ws + WS_ATT), (const char*)(ws + WS_WFO), (const char*)(ws + WS_WAO), G, bx};
    EpiMergeBr E{EpiMerge{ws, (const bf16_t*)p.out}};
    g8::gemm_phase<EpiMergeBr, SchedMerge2, 1024, 1024, false, KREP_[4], false>(lds, S, E);
}
__device__ __forceinline__ void ph_outproj(const Params& p, LAS unsigned char* lds, int G, int bx) {
    unsigned char* ws = p.ws;
    typedef SchedGrid<M / 256, D / 256, D / 64, D, D> SG; SG S{(const char*)(ws + WS_MERGED), (const char*)(ws + WS_WOUT), G, bx};
    EpiX1 E{XIn{p.xp, p.xs}, ws};
    g8::gemm_phase<EpiX1, SG, D, D, false, KREP_[5]>(lds, S, E);
}
__device__ __forceinline__ void ph_up(const Params& p, LAS unsigned char* lds, int G, int bx, int vcu, int tid) {
    unsigned char* ws = p.ws;
    {
        const float* SSQ = (const float*)(ws + WS_SSQ); float* r2 = (float*)(ws + T_RSTD2);
        for (int r = vcu * NTHR + tid; r < M; r += G * NTHR) { const f32x4* q = (const f32x4*)(SSQ + (size_t)r * 32); float s = 0.f;
#pragma unroll
            for (int j = 0; j < 8; ++j) { const f32x4 v = q[j]; s += (v[0] + v[1]) + (v[2] + v[3]); }
            r2[r] = 1.f / (s * (1.f / D) + EPS); }
    }
    typedef SchedGrid<M / 256, DFF / 256, D / 64, D, D> SG; SG S{(const char*)(ws + WS_X1B), (const char*)(ws + WS_W1), G, bx};
    EpiRelu2 E{(bf16_t*)(ws + WS_U), (bf16_t*)p.out};
    g8::gemm_phase<EpiRelu2, SG, D, D, false, KREP_[6]>(lds, S, E);
}
__device__ __forceinline__ void ph_down(const Params& p, LAS unsigned char* lds, int G, int bx) {
    unsigned char* ws = p.ws;
    SchedDown S{(const char*)(ws + WS_U), (const char*)p.out, (const char*)(ws + WS_W2), G, bx};
    EpiDown E{p.out, ws, (unsigned*)(ws + WS_CTL) + CW_PANEL};
    g8::gemm_phase<EpiDown, SchedDown, 4096, DFF, false, KREP_[7]>(lds, S, E);
}

__global__ void __launch_bounds__(NTHR, 2) __attribute__((target("no-packed-fp32-ops"))) mk_fwd(Params p) {
    extern __shared__ __attribute__((aligned(16))) unsigned char lds_raw[];
    LAS unsigned char* lds = (LAS unsigned char*)lds_raw;
    const int tid = threadIdx.x, lane = tid & 63, wave = __builtin_amdgcn_readfirstlane(tid >> 6);
    const int G = gridDim.x, bx = blockIdx.x;
    const int vcu = (G % 8 == 0) ? (bx % 8) * (G / 8) + bx / 8 : bx;
    const int gw = vcu * NWAVES + wave, NGW = G * NWAVES;
    unsigned char* ws = p.ws;
    volatile LAS unsigned* MISC = (volatile LAS unsigned*)(lds + LDSCTL_OFF);
    if (tid < 64) MISC[tid] = 0u;
    __syncthreads();
    unsigned* ctl = (unsigned*)(ws + WS_CTL);
    XcdBarrier bar = xcd_barrier_post(ctl + CW_BAR + p.li * XCD_BAR_WORDS, MISC + 8);
    const int lo = p.ph_lo, hi = p.ph_hi;
#define IN(k) (lo <= (k) && (k) < hi)
#define SEAM(k) do { if (IN(k) && IN((k) + 1)) xcd_barrier(bar); } while (0)

#define PHASE(k, body) do { if (IN(k)) { body; } SEAM(k); } while (0)
    PHASE(0, p0_prologue(p, lds, gw, NGW, lane, wave));
    PHASE(1, ph_inproj(p, lds, G, bx));
    PHASE(2, { const bool fft_first = bx & 1;     if (!fft_first) natten_phase(p, lds, G, vcu, tid, lane, wave); fft_phase(p, lds, G, bx, tid, lane, wave); if (fft_first) natten_phase(p, lds, G, vcu, tid, lane, wave); });
    PHASE(3, ph_chdft(p, lds, G, bx, tid));
    PHASE(4, ph_merge(p, lds, G, bx));
    PHASE(5, ph_outproj(p, lds, G, bx));
    PHASE(6, ph_up(p, lds, G, bx, vcu, tid));
    PHASE(7, ph_down(p, lds, G, bx));
#ifdef MK_PROBE_SUBPHASES
    if (IN(8)) { fft_phase(p, lds, G, bx, tid, lane, wave); }
    if (IN(9)) { natten_phase(p, lds, G, bx, tid, lane, wave); }
#endif
#undef PHASE
#undef IN
#undef SEAM
}

extern "C" void kernel_launch(void* const* d_in, const int* in_sizes, int n_in, void* d_out, int out_size, void* d_ws, size_t ws_size, hipStream_t stream) {
    static int grid = 0;
    if (grid == 0) {
        if (n_in != 13 || ws_size < WS_END || out_size != M * D) { fprintf(stderr, "kernel_launch: unexpected sizes n_in %d ws %zu out %d\n", n_in, ws_size, out_size); grid = -1; return; }
        int dev = 0, cus = 0, per_cu = 0;
        if (hipGetDevice(&dev) != hipSuccess || hipDeviceGetAttribute(&cus, hipDeviceAttributeMultiprocessorCount, dev) != hipSuccess) { grid = -1; return; }
        if (hipFuncSetAttribute((const void*)mk_fwd, hipFuncAttributeMaxDynamicSharedMemorySize, LDS_BYTES) != hipSuccess) { fprintf(stderr, "kernel_launch: hipFuncSetAttribute failed\n"); grid = -1; return; }
        if (hipOccupancyMaxActiveBlocksPerMultiprocessor(&per_cu, (const void*)mk_fwd, NTHR, LDS_BYTES) != hipSuccess || per_cu < 1) fprintf(stderr, "kernel_launch: occupancy query says %d\n", per_cu);
        (void)hipGetLastError();
        grid = cus;
        if (grid != 256) { fprintf(stderr, "kernel_launch: built for a 256-CU device (MI355X), found %d CUs; nothing launched\n", cus); grid = -1; return; }
    }
    if (grid < 0) return;
    const float* xp = (const float*)d_in[0]; const float* xs = (const float*)d_in[1];
    const float* g_mix = (const float*)d_in[2]; const float* w_in = (const float*)d_in[3];
    const float* q_norm = (const float*)d_in[4]; const float* k_norm = (const float*)d_in[5]; const float* rpb = (const float*)d_in[6];
    const float* w_fo = (const float*)d_in[7]; const float* w_ao = (const float*)d_in[8]; const float* w_out = (const float*)d_in[9];
    const float* g_mlp = (const float*)d_in[10]; const float* w1 = (const float*)d_in[11]; const float* w2 = (const float*)d_in[12];
    unsigned char* ws = (unsigned char*)d_ws; float* out = (float*)d_out;

    hipMemsetAsync(ws + WS_CTL, 0, CTL_ZERO_BYTES, stream);
    Params prm{}; prm.xp = xp; prm.xs = xs; prm.g_mix = g_mix; prm.w_in = w_in; prm.q_norm = q_norm; prm.k_norm = k_norm; prm.rpb = rpb; prm.w_fo = w_fo; prm.w_ao = w_ao; prm.w_out = w_out;
    prm.g_mlp = g_mlp; prm.w1 = w1; prm.w2 = w2; prm.out = out; prm.ws = ws;
    int n_mk = 0;
#define MK(lo_, hi_) do { prm.ph_lo = lo_; prm.ph_hi = hi_; prm.li = n_mk++; hipLaunchKernelGGL(mk_fwd, dim3(grid), dim3(NTHR), LDS_BYTES, stream, prm); } while (0)
    constexpr int PLAN[][2] = {{0, 8}};
    for (auto& pl : PLAN) MK(pl[0], pl[1]);
}
```

```cpp
#include <hip/hip_runtime.h>
#include <cstdio>
#include <cstdint>

typedef unsigned short bf16_t;
typedef short bf16x8 __attribute__((ext_vector_type(8)));
typedef short s16x4 __attribute__((ext_vector_type(4)));
typedef float f32x2 __attribute__((ext_vector_type(2)));
typedef float f32x4 __attribute__((ext_vector_type(4)));
typedef float f32x16 __attribute__((ext_vector_type(16)));
typedef unsigned u32x2 __attribute__((ext_vector_type(2)));
typedef unsigned u32x4 __attribute__((ext_vector_type(4)));
#define LAS __attribute__((address_space(3)))
#define GAS __attribute__((address_space(1)))

constexpr int D = 2048, SEQ = 8192, NB = 3, M = NB * SEQ;
constexpr int NH = 16, HD = 64, AW = 1024, FW = 1024, INW = 8192, DFF = 8192;
constexpr float EPS = 1e-6f;
constexpr float LOG2E = 1.4426950408889634f;
constexpr float QSCALE = 0.125f * LOG2E;
constexpr float S_ORTHO = 6.905339660024878e-4f;

constexpr size_t MiB = 1u << 20;
constexpr size_t WS_CTL = 0, CTL_ZERO_BYTES = 65536;
constexpr size_t WS_TAB = 1 * MiB;
constexpr size_t T_RSTD1 = WS_TAB, T_RSTD2 = WS_TAB + 98304;
constexpr size_t T_DFTC = WS_TAB + 196608, T_DFTS = WS_TAB + 327680;
constexpr size_t T_F128C = WS_TAB + 458752, T_F128S = WS_TAB + 491520;
constexpr size_t T_F64 = WS_TAB + 524288;
constexpr size_t T_RPB = WS_TAB + 557056;
constexpr size_t T_TW = WS_TAB + 589824;
constexpr size_t T_CS = WS_TAB + 1048576;
constexpr size_t T_P4096 = WS_TAB + 1048576 + 524288;
constexpr size_t WS_SSQ = 3 * MiB;
constexpr size_t WS_WIN = 6 * MiB, WS_WFO = 38 * MiB, WS_WAO = 42 * MiB, WS_WOUT = 54 * MiB, WS_W1 = 62 * MiB, WS_W2 = 94 * MiB;
constexpr size_t WS_B = 126 * MiB, WS_Q = WS_B, WS_K = WS_B + 48 * MiB, WS_V = WS_B + 96 * MiB, WS_MERGED = WS_B;
constexpr size_t WS_A = 270 * MiB, WS_XB = WS_A, WS_PT = WS_A;
constexpr size_t WS_C = 366 * MiB, WS_FT = WS_C, WS_FM = WS_C;
constexpr size_t WS_D = 414 * MiB, WS_ATT = WS_D, WS_X1B = WS_D;
constexpr size_t WS_U = 126 * MiB;
constexpr size_t WS_TMP0 = 6 * MiB, WS_TMP1 = 318 * MiB;
constexpr size_t WS_END = 510 * MiB;
constexpr int ATT_LD = 1024;
constexpr size_t WS_Y = 366 * MiB;

__device__ __forceinline__ float bf2f(bf16_t v) { return __uint_as_float((unsigned)v << 16); }
__device__ __forceinline__ bf16_t f2bf(float f) { unsigned u = __float_as_uint(f); return (bf16_t)((u + 0x7fffu + ((u >> 16) & 1u)) >> 16); }
__device__ __forceinline__ unsigned pk2(float lo, float hi) { return (unsigned)f2bf(lo) | ((unsigned)f2bf(hi) << 16); }

struct XIn { const float* xp; const float* xs; __device__ __forceinline__ const float* row(int m) const { return m < SEQ ? xp + (size_t)m * D : xs + (size_t)(m - SEQ) * D; } };

namespace g8 {
constexpr int BM = 256, BK = 64, HALF = 128, HTB = HALF * BK * 2, STAGE_BYTES = 8 * HTB, NXCD = 8, WGM = 4;

__host__ __device__ __forceinline__ int lds_byte(int r, int c) { const int st = (r >> 4) * 2 + (c >> 5), rr = r & 15, cc = c & 31, ob = rr * 64 + cc * 2; return st * 1024 + (ob ^ (((ob >> 9) & 1) << 5)); }
__host__ __device__ __forceinline__ void stage_rc(int b, int& R, int& C) { const int st = b / 1024, sb = b % 1024, swz = sb ^ (((sb >> 9) & 1) << 5); R = (st >> 1) * 16 + swz / 64; C = (st & 1) * 32 + (swz % 64) / 2; }
__host__ __device__ __forceinline__ int perm32(int rho) { const int n = rho >> 4, i = rho & 15; return 8 * (i >> 2) + 4 * n + (i & 3); }

struct Unit { const char* a; const char* b; int pm, pn, nt, keep, br; };

template <int WG = WGM> __device__ __forceinline__ void tile_of(int L, int nM, int nN, int& pm, int& pn) {
    const int nwg = nM * nN; int wgid = L;
    { const int q = nwg / NXCD, r = nwg % NXCD, xcd = wgid % NXCD, off = wgid / NXCD; wgid = (xcd < r ? xcd * (q + 1) : r * (q + 1) + (xcd - r) * q) + off; }
    const int nig = WG * nN, gid = wgid / nig, fm = gid * WG, gsz = (nM - fm) < WG ? (nM - fm) : WG;
    pm = fm + ((wgid % nig) % gsz); pn = (wgid % nig) / gsz;
}

typedef __bf16 bf16x2_t __attribute__((ext_vector_type(2)));
__device__ __forceinline__ unsigned cvt_pk_bf16(float lo, float hi) { f32x2 v = {lo, hi}; bf16x2_t b = __builtin_convertvector(v, bf16x2_t); return __builtin_bit_cast(unsigned, b); }

template <bool HEAD64> __device__ __forceinline__ int colbase(int bj, int wc, int fq) { return HEAD64 ? (64 * wc + 32 * bj + 8 * fq) : (128 * bj + 32 * wc + 8 * fq); }

template <class Epi, class Sched, int lda, int ldb, bool HEAD64, int KREP = 1, bool AKM = false>
__device__ __forceinline__ void gemm_phase(LAS unsigned char* lds, const Sched& S, const Epi& E) {
    const int tid = threadIdx.x, wid = __builtin_amdgcn_readfirstlane(tid >> 6), lane = tid & 63, wr = wid >> 2, wc = wid & 3, fr = lane & 15, fq = lane >> 4;
    Unit cur, nxt; int ui = 0; bool prev_keep = false;
    if (!S.next(0, cur)) return;
    unsigned voffB[2], voffA[2];
#pragma unroll
    for (int i = 0; i < 2; ++i) { int R, C; stage_rc(tid * 16 + i * 8192, R, C);
        const int Rb = HEAD64 ? ((R >> 5) * 64 + perm32(R & 31)) : ((R & ~31) + perm32(R & 31));
        voffB[i] = (unsigned)(Rb * ldb + C) * 2u; voffA[i] = (unsigned)(R * lda + C) * 2u;
        if (AKM) { const int pb = tid * 16 + i * 8192, krow = pb >> 8, c16s = (pb >> 4) & 15, f = (krow & 3) | (((krow >> 3) & 1) << 2), c16 = (((c16s >> 1) ^ f) << 1) | (c16s & 1);
            voffA[i] = (unsigned)(krow * lda + c16 * 8) * 2u; } }
    const size_t kstep = (size_t)(BK * 2), kstepA = AKM ? (size_t)BK * lda * 2 : kstep;
    const size_t hB = (size_t)(HEAD64 ? 32 : HALF) * ldb * 2;
    const size_t hA = AKM ? (size_t)HALF * 2 : (size_t)HALF * lda * 2;
    const int akoff = ((8 * fq + (fr >> 2)) << 8) + 8 * (fr & 3), akf = (fr >> 2) | ((fq & 1) << 2);
    const unsigned ldsw = (unsigned)wid * 1024u;
    const int aoff = lds_byte(wr * 64 + fr, fq * 8), boff = lds_byte(wc * 32 + fr, fq * 8);
#define G8_SA(b, h) (((b) * 2 + (h)) * HTB)
#define G8_SB(b, h) ((4 + (b) * 2 + (h)) * HTB)
#define G8_STAGE(bufoff, gbase, voff) do { const char* sb_ = (const char*)(gbase); asm volatile("" : "+s"(sb_));     \
        _Pragma("unroll") for (int _i = 0; _i < 2; ++_i) { unsigned vo_ = (voff)[_i]; asm volatile("" : "+v"(vo_));     \
        __builtin_amdgcn_global_load_lds((const unsigned*)(sb_ + vo_), (LAS unsigned*)(lds + (bufoff) + ldsw + _i * 8192), 16, 0, 0); } } while (0)
#define G8_TR(d_, a_, off_) asm volatile("ds_read_b64_tr_b16 %0, %1 offset:%2" : "=v"(d_) : "v"(a_), "n"(off_) : "memory")
#define G8_PINA do { if constexpr (AKM) asm volatile("s_waitcnt lgkmcnt(0)" : "+v"(At[0][0]), "+v"(At[0][1]), "+v"(At[1][0]), "+v"(At[1][1]), "+v"(At[2][0]), "+v"(At[2][1]), "+v"(At[3][0]), "+v"(At[3][1]) :: "memory"); } while (0)
#define G8_LDA(dst, b, h) do { if constexpr (!AKM) { _Pragma("unroll") for (int m = 0; m < 4; ++m) _Pragma("unroll") for (int k = 0; k < 2; ++k) dst[m][k] = *(const LAS bf16x8*)(lds + G8_SA(b, h) + aoff + m * 2048 + k * 1024); } \
    else { _Pragma("unroll") for (int m = 0; m < 4; ++m) { const unsigned ab_ = (unsigned)(size_t)lds + (unsigned)(akoff + (((4 * wr + m) ^ akf) << 5)); s16x4 l0_, h0_, l1_, h1_; \
        G8_TR(l0_, ab_, G8_SA(b, h)); G8_TR(h0_, ab_, G8_SA(b, h) + 1024); G8_TR(l1_, ab_, G8_SA(b, h) + 8192); G8_TR(h1_, ab_, G8_SA(b, h) + 8192 + 1024); \
        dst[m][0] = (bf16x8){l0_[0], l0_[1], l0_[2], l0_[3], h0_[0], h0_[1], h0_[2], h0_[3]}; dst[m][1] = (bf16x8){l1_[0], l1_[1], l1_[2], l1_[3], h1_[0], h1_[1], h1_[2], h1_[3]}; } } } while (0)
#define G8_LDB(dst, b, h) do { _Pragma("unroll") for (int n = 0; n < 2; ++n) _Pragma("unroll") for (int k = 0; k < 2; ++k) dst[n][k] = *(const LAS bf16x8*)(lds + G8_SB(b, h) + boff + n * 2048 + k * 1024); } while (0)
#define G8_MMA(ai, bj, At, Bt) do { __builtin_amdgcn_s_setprio(1); _Pragma("unroll") for (int m = 0; m < 4; ++m) _Pragma("unroll") for (int n = 0; n < 2; ++n) _Pragma("unroll") for (int k = 0; k < 2; ++k) \
        acc[ai][bj][m][n] = __builtin_amdgcn_mfma_f32_16x16x32_bf16(Bt[n][k], At[m][k], acc[ai][bj][m][n], 0, 0, 0); __builtin_amdgcn_s_setprio(0); } while (0)
#define G8_WAIT_V(n) asm volatile("s_waitcnt vmcnt(" #n ")" ::: "memory")
#define G8_WAIT_L(n) asm volatile("s_waitcnt lgkmcnt(" #n ")" ::: "memory")
#define G8_BAR __builtin_amdgcn_s_barrier()
#define G8_SCHED __builtin_amdgcn_sched_barrier(0)
    f32x4 acc[2][2][4][2];
#pragma unroll
    for (int a = 0; a < 2; ++a)
#pragma unroll
        for (int b = 0; b < 2; ++b)
#pragma unroll
            for (int m = 0; m < 4; ++m)
#pragma unroll
                for (int n = 0; n < 2; ++n) acc[a][b][m][n] = (f32x4){0.f, 0.f, 0.f, 0.f};
    bf16x8 At[4][2], B0[2][2], B1[2][2];
    const char* cA = cur.a; const char* cB = cur.b;
    G8_STAGE(G8_SB(0, 0), cB, voffB); G8_STAGE(G8_SB(0, 1), cB + hB, voffB); G8_STAGE(G8_SA(0, 0), cA, voffA); G8_STAGE(G8_SA(0, 1), cA + hA, voffA);
    if (wr == 1) G8_BAR;
    G8_WAIT_V(2); G8_BAR;
    G8_STAGE(G8_SB(1, 0), cB + kstep, voffB); G8_STAGE(G8_SA(1, 0), cA + kstepA, voffA); G8_STAGE(G8_SB(1, 1), cB + hB + kstep, voffB);
    G8_WAIT_V(6); G8_BAR;
    for (;;) {
        const bool has_next = S.next(ui + 1, nxt);
        const char* nA = has_next ? nxt.a : cA; const char* nB = has_next ? nxt.b : cB;
        const int nt1 = cur.nt, nt = nt1 * KREP;
        for (int t = 0; t < nt; t += 2) {
            const bool last = (t == nt - 2);
            const int t1 = (KREP > 1 && t + 1 >= nt1) ? t + 1 - nt1 : t + 1, t2 = (KREP > 1 && t + 2 >= nt1) ? t + 2 - nt1 : t + 2;
            const char* a1 = cA + (size_t)t1 * kstepA;
            const char* a2 = last ? nA : cA + (size_t)t2 * kstepA; const char* b2 = last ? nB : cB + (size_t)t2 * kstep;
            const char* a3 = a2 + kstepA; const char* b3 = b2 + kstep;
            const bool relax = (t == 0) && (ui > 0) && !(Sched::HAS_KEEP && prev_keep);
            G8_LDB(B0, 0, 0); G8_LDB(B1, 0, 1); G8_SCHED; G8_LDA(At, 0, 0); G8_STAGE(G8_SA(1, 1), a1 + hA, voffA);
            if (relax) G8_WAIT_V(24); else G8_WAIT_V(8);
            G8_WAIT_L(0); G8_PINA; G8_BAR; G8_MMA(0, 0, At, B0); G8_MMA(0, 1, At, B1); G8_BAR; G8_SCHED;
            G8_LDA(At, 0, 1); G8_STAGE(G8_SB(0, 0), b2, voffB); G8_STAGE(G8_SB(0, 1), b2 + hB, voffB); G8_STAGE(G8_SA(0, 0), a2, voffA);
            if (relax) G8_WAIT_V(24); else G8_WAIT_V(8);
            G8_WAIT_L(0); G8_PINA; G8_BAR; G8_MMA(1, 0, At, B0); G8_MMA(1, 1, At, B1); G8_BAR; G8_SCHED;
            G8_LDB(B0, 1, 0); G8_LDB(B1, 1, 1); G8_SCHED; G8_LDA(At, 1, 0); G8_STAGE(G8_SA(0, 1), a2 + hA, voffA);
            G8_WAIT_V(8); G8_WAIT_L(0); G8_PINA; G8_BAR; G8_MMA(0, 0, At, B0); G8_MMA(0, 1, At, B1); G8_BAR; G8_SCHED;
            G8_LDA(At, 1, 1); G8_STAGE(G8_SB(1, 0), b3, voffB); G8_STAGE(G8_SB(1, 1), b3 + hB, voffB); G8_STAGE(G8_SA(1, 0), a3, voffA);
            G8_WAIT_V(8); G8_WAIT_L(0); G8_PINA; G8_BAR; G8_MMA(1, 0, At, B0); G8_MMA(1, 1, At, B1); G8_BAR; G8_SCHED;
        }
        if (wr == 0) G8_BAR;
        if (KREP > 1) {
#pragma unroll
            for (int a = 0; a < 2; ++a)
#pragma unroll
                for (int b = 0; b < 2; ++b)
#pragma unroll
                    for (int m = 0; m < 4; ++m)
#pragma unroll
                        for (int n = 0; n < 2; ++n) acc[a][b][m][n] *= (1.f / KREP); }
        E(acc, cur, wr, wc, fr, fq);
        if (!has_next) break;
        if constexpr (Sched::HAS_KEEP) prev_keep = cur.keep != 0;
        if (!(Sched::HAS_KEEP && prev_keep)) {
#pragma unroll
        for (int a = 0; a < 2; ++a)
#pragma unroll
            for (int b = 0; b < 2; ++b)
#pragma unroll
                for (int m = 0; m < 4; ++m)
#pragma unroll
                    for (int n = 0; n < 2; ++n) acc[a][b][m][n] = (f32x4){0.f, 0.f, 0.f, 0.f};
        }
        cur = nxt; cA = nA; cB = nB; ++ui;
        if (wr == 1) G8_BAR;
    }
    G8_WAIT_V(0);
    G8_BAR;
#undef G8_SA
#undef G8_SB
#undef G8_STAGE
#undef G8_LDA
#undef G8_TR
#undef G8_PINA
#undef G8_LDB
#undef G8_MMA
#undef G8_WAIT_V
#undef G8_WAIT_L
#undef G8_BAR
#undef G8_SCHED
}
}

#define XB_TMO      128
#define XB_XCNT(j)  (256  + 64 * (j))
#define XB_XSUB(j)  (1280 + 64 * (j))
#define XB_XGEN(j)  (2304 + 64 * (j))
#define XB_TOP      3328
#define XB_TOPGEN   3392
#define XCD_BAR_WORDS 3456
#define XB_SPIN_CAP (1u << 18)

__device__ __forceinline__ unsigned xb_ld(unsigned* p)              { return __hip_atomic_load(p, __ATOMIC_RELAXED, __HIP_MEMORY_SCOPE_AGENT); }
__device__ __forceinline__ unsigned xb_add(unsigned* p, unsigned v) { return __hip_atomic_fetch_add(p, v, __ATOMIC_RELAXED, __HIP_MEMORY_SCOPE_AGENT); }
__device__ __forceinline__ unsigned xb_xcc_id() { return (unsigned)__builtin_amdgcn_s_getreg((3 << 11) | 20) & 0xFu; }
#define XB_SPIN(cond, bar) do { unsigned _sp = 0; while (cond) { __builtin_amdgcn_s_sleep(1); \
    if ((++_sp & 255u) == 0u) { if (xb_ld(&(bar)[XB_TMO])) break; if (_sp > XB_SPIN_CAP) { atomicAdd(&(bar)[XB_TMO], 1u); break; } } } } while (0)

struct XcdBarrier { unsigned* bar; unsigned x; volatile LAS unsigned* st; };

__device__ __forceinline__ XcdBarrier xcd_barrier_post(unsigned* bar, volatile LAS unsigned* st) {
    XcdBarrier b; b.bar = bar; b.x = xb_xcc_id(); b.st = st;
    if (threadIdx.x == 0) (void)xb_add(&bar[XB_XCNT(b.x)], 1u);
    return b;
}
__device__ __forceinline__ void xcd_barrier_complete(unsigned* bar, unsigned x, unsigned& nloc, unsigned& nx) {
    const unsigned G = gridDim.x * gridDim.y * gridDim.z;
    unsigned sum, cnt, mine, sp = 0u;
    for (;;) {
        sum = 0u; cnt = 0u; mine = 0u;
#pragma unroll
        for (unsigned j = 0; j < 16; ++j) { const unsigned c = xb_ld(&bar[XB_XCNT(j)]); sum += c; cnt += (c > 0u) ? 1u : 0u; mine = (j == x) ? c : mine; }
        if (sum == G) break;
        __builtin_amdgcn_s_sleep(1);
        if ((++sp & 255u) == 0u) { if (xb_ld(&bar[XB_TMO])) break; if (sp > XB_SPIN_CAP) { atomicAdd(&bar[XB_TMO], 1u); break; } }
    }
    nloc = mine > 0u ? mine : 1u; nx = cnt > 0u ? cnt : 1u;
}
__device__ __forceinline__ void xcd_barrier(const XcdBarrier& b) {
    asm volatile("s_waitcnt vmcnt(0)" ::: "memory");
    __syncthreads();
    if (threadIdx.x == 0) {
        unsigned* bar = b.bar;
        __builtin_amdgcn_s_waitcnt(0);
        unsigned nloc = b.st[0], nx = b.st[1];
        if (nloc == 0u) { xcd_barrier_complete(bar, b.x, nloc, nx); b.st[0] = nloc; b.st[1] = nx; }
        const unsigned old = xb_add(&bar[XB_XSUB(b.x)], 1u);
        const unsigned gen = old / nloc;
        if (old + 1u == (gen + 1u) * nloc) {
            __builtin_amdgcn_fence(__ATOMIC_RELEASE, "agent");
            asm volatile("s_waitcnt vmcnt(0)" ::: "memory");
            const unsigned og = xb_add(&bar[XB_TOP], 1u);
            const unsigned tg = og / nx;
            if (og + 1u == (tg + 1u) * nx) xb_add(&bar[XB_TOPGEN], 1u);
            else XB_SPIN(xb_ld(&bar[XB_TOPGEN]) == tg, bar);
            __builtin_amdgcn_fence(__ATOMIC_ACQUIRE, "agent");
            xb_add(&bar[XB_XGEN(b.x)], 1u);
            asm volatile("s_waitcnt vmcnt(0)" ::: "memory");
        } else {
            XB_SPIN(xb_ld(&bar[XB_XGEN(b.x)]) == gen, bar);
            __builtin_amdgcn_fence(__ATOMIC_ACQUIRE, "agent");
            asm volatile("s_waitcnt vmcnt(0)" ::: "memory");
        }
    }
    __syncthreads();
}

constexpr int NWAVES = 8, NTHR = 512;
constexpr int RING_BYTES = 131072, XTRA_OFF = RING_BYTES, LDSCTL_OFF = 163840 - 256, LDS_BYTES = 163840;
constexpr int CW_BAR = 4096, CW_PANEL = 12288;
constexpr int NPH = 8;
constexpr int NAT_REP = 1;
constexpr int FFT_REP = 1;
constexpr int KREP_[NPH] = {1, 1, 1, 1, 1, 1, 1, 1};

struct Params { const float *xp, *xs, *g_mix, *w_in, *q_norm, *k_norm, *rpb, *w_fo, *w_ao, *w_out, *g_mlp, *w1, *w2; float* out; unsigned char* ws; int ph_lo, ph_hi, li, pad; };

__device__ __forceinline__ float xsum16(float v) { const auto r = __builtin_amdgcn_permlane16_swap(__float_as_uint(v), __float_as_uint(v), false, false); return __uint_as_float(r[0]) + __uint_as_float(r[1]); }
__device__ __forceinline__ float xsum32(float v) { const auto r = __builtin_amdgcn_permlane32_swap(__float_as_uint(v), __float_as_uint(v), false, false); return __uint_as_float(r[0]) + __uint_as_float(r[1]); }
__device__ __forceinline__ float xmax16(float v) { const auto r = __builtin_amdgcn_permlane16_swap(__float_as_uint(v), __float_as_uint(v), false, false); return fmaxf(__uint_as_float(r[0]), __uint_as_float(r[1])); }
__device__ __forceinline__ float xmax32(float v) { const auto r = __builtin_amdgcn_permlane32_swap(__float_as_uint(v), __float_as_uint(v), false, false); return fmaxf(__uint_as_float(r[0]), __uint_as_float(r[1])); }
__device__ __forceinline__ float wave_sum(float v) {
#pragma unroll
    for (int o = 1; o < 64; o <<= 1) v += __shfl_xor(v, o);
    return v;
}
#define LDS_WAIT() asm volatile("s_waitcnt lgkmcnt(0)" ::: "memory")

struct WItem { const float* src; const float* gain; bf16_t* dst; int N, ldo; float sc; };
__device__ __forceinline__ bool p0_resolve(const Params& p, int it, WItem& w) {
    unsigned char* ws = p.ws;
    constexpr int I_IN = (D / 64) * (INW / 32), I_FO = (FW / 64) * (D / 32), I_AO = I_FO, I_OUT = (D / 64) * (D / 32), I_1 = (D / 64) * (DFF / 32), I_2 = (DFF / 64) * (D / 32);
    int r = it; const float* W; const float* g; bf16_t* WT; int N, ldo, co;
    if (r < I_IN) { W = p.w_in; g = p.g_mix; WT = (bf16_t*)(ws + WS_WIN); N = INW; ldo = D; co = 0; }
    else if ((r -= I_IN) < I_FO) { W = p.w_fo; g = nullptr; WT = (bf16_t*)(ws + WS_WFO); N = D; ldo = FW; co = 0; }
    else if ((r -= I_FO) < I_AO) { W = p.w_ao; g = nullptr; WT = (bf16_t*)(ws + WS_WAO); N = D; ldo = AW; co = 0; }
    else if ((r -= I_AO) < I_OUT) { W = p.w_out; g = nullptr; WT = (bf16_t*)(ws + WS_WOUT); N = D; ldo = D; co = 0; }
    else if ((r -= I_OUT) < I_1) { W = p.w1; g = p.g_mlp; WT = (bf16_t*)(ws + WS_W1); N = DFF; ldo = D; co = 0; }
    else if ((r -= I_1) < I_2) { W = p.w2; g = nullptr; WT = (bf16_t*)(ws + WS_W2); N = D; ldo = DFF; co = 0; }
    else return false;
    const int nblk = N / 32, kb = r / nblk, nb = r % nblk, k0 = 64 * kb, n0 = 32 * nb;
    w.src = W + (size_t)k0 * N + n0; w.gain = g ? g + k0 : nullptr; w.dst = WT + (size_t)n0 * ldo + co + k0; w.N = N; w.ldo = ldo; w.sc = (W == p.w_in && n0 >= 4096) ? -LOG2E : 1.f;
    return true;
}
__device__ __forceinline__ void p0_load(const WItem& w, f32x4 (&v)[8], float (&g)[8], int lane) {
#pragma unroll
    for (int j = 0; j < 8; ++j) { const int kk = (lane >> 3) + 8 * j; v[j] = *(const f32x4*)(w.src + (size_t)kk * w.N + (lane & 7) * 4); g[j] = (w.gain ? w.gain[kk] : 1.f) * w.sc; }
}
__device__ __forceinline__ void p0_process(const WItem& w, const f32x4 (&v)[8], const float (&g)[8], LAS float* scr, int lane) {
#pragma unroll
    for (int j = 0; j < 8; ++j) { const int kk = (lane >> 3) + 8 * j; LAS float* d = scr + kk * 33 + (lane & 7) * 4; const f32x4 x = v[j] * g[j]; d[0] = x[0]; d[1] = x[1]; d[2] = x[2]; d[3] = x[3]; }
    LDS_WAIT(); asm volatile("" ::: "memory");
    const int c = lane & 7;
#pragma unroll
    for (int j = 0; j < 4; ++j) { const int n = (lane >> 3) + 8 * j; const LAS float* s = scr + (8 * c) * 33 + n;
        u32x4 o; o.x = g8::cvt_pk_bf16(s[0 * 33], s[1 * 33]); o.y = g8::cvt_pk_bf16(s[2 * 33], s[3 * 33]); o.z = g8::cvt_pk_bf16(s[4 * 33], s[5 * 33]); o.w = g8::cvt_pk_bf16(s[6 * 33], s[7 * 33]);
        *(u32x4*)(w.dst + (size_t)n * w.ldo + 8 * c) = o; }
    LDS_WAIT(); asm volatile("" ::: "memory");
}
__device__ __forceinline__ void p0_xrow(const f32x4 (&v)[8], float* rstd1, bf16_t* XB, int m, int lane) {
    float s = 0.f;
#pragma unroll
    for (int j = 0; j < 8; ++j) s += (v[j].x * v[j].x + v[j].y * v[j].y) + (v[j].z * v[j].z + v[j].w * v[j].w);
    s = wave_sum(s);
    const float rs = rsqrtf(s * (1.f / D) + EPS);
    u32x2* o8 = (u32x2*)(XB + (size_t)m * D) + lane;
#pragma unroll
    for (int j = 0; j < 8; ++j) { u32x2 w; w.x = g8::cvt_pk_bf16(v[j].x * rs, v[j].y * rs); w.y = g8::cvt_pk_bf16(v[j].z * rs, v[j].w * rs); o8[64 * j] = w; }
}
__device__ __forceinline__ void p0_prologue(const Params& p, LAS unsigned char* lds, int gw, int NGW, int lane, int wave) {
    unsigned char* ws = p.ws;
    LAS float* scr = (LAS float*)(lds + wave * 16384);
    {
        WItem wa, wb; f32x4 va[8], vb[8]; float ga[8], gb[8];
        int it = gw; bool ha = p0_resolve(p, it, wa); if (ha) p0_load(wa, va, ga, lane);
        while (ha) {
            const bool hb = p0_resolve(p, it + NGW, wb); if (hb) p0_load(wb, vb, gb, lane);
            p0_process(wa, va, ga, scr, lane);
            if (!hb) break;
            it += 2 * NGW; ha = p0_resolve(p, it, wa); if (ha) p0_load(wa, va, ga, lane);
            p0_process(wb, vb, gb, scr, lane);
        }
    }
    XIn x{p.xp, p.xs}; float* rstd1 = (float*)(ws + T_RSTD1); bf16_t* XB = (bf16_t*)(ws + WS_XB);
    {
        f32x4 va[8], vb[8]; int m = gw;
        if (m < M) {
#pragma unroll
            for (int j = 0; j < 8; ++j) va[j] = ((const f32x4*)x.row(m) + lane)[64 * j]; }
        while (m < M) {
            const int m2 = m + NGW;
            if (m2 < M) {
#pragma unroll
                for (int j = 0; j < 8; ++j) vb[j] = ((const f32x4*)x.row(m2) + lane)[64 * j]; }
            p0_xrow(va, rstd1, XB, m, lane);
            if (m2 >= M) break;
            m = m2 + NGW;
            if (m < M) {
#pragma unroll
                for (int j = 0; j < 8; ++j) va[j] = ((const f32x4*)x.row(m) + lane)[64 * j]; }
            p0_xrow(vb, rstd1, XB, m2, lane);
        }
    }
    bf16_t* Tc = (bf16_t*)(ws + T_DFTC); bf16_t* Ts = (bf16_t*)(ws + T_DFTS);
    for (int i = gw * 64 + lane; i < 65536; i += NGW * 64) { const int a = ((i >> 8) * (i & 255)) & 255; const float ang = (float)a * (1.f / 128.f);
        Tc[i] = f2bf(cospif(ang) * S_ORTHO); Ts[i] = f2bf(sinpif(ang) * S_ORTHO); }
    { bf16_t* Tcs = (bf16_t*)(ws + T_CS);
      for (int i = gw * 64 + lane; i < 2 * 256 * 512; i += NGW * 64) { const int k = i & 511, n = (i >> 9) & 255, hh = i >> 17, cp = 128 * hh + (n & 127), a = (cp * (k & 255)) & 255; const float ang = (float)a * (1.f / 128.f);
          Tcs[i] = f2bf(k < 256 ? cospif(ang) * S_ORTHO : (n < 128 ? sinpif(ang) : -sinpif(ang)) * S_ORTHO); } }
    bf16_t* F128C = (bf16_t*)(ws + T_F128C); bf16_t* F128S = (bf16_t*)(ws + T_F128S); bf16_t* F64T = (bf16_t*)(ws + T_F64);
    for (int i = gw * 64 + lane; i < 16384; i += NGW * 64) { const int a = ((i >> 7) * (i & 127)) & 127; const float ang = (float)a * (1.f / 64.f);
        F128C[i] = f2bf(cospif(ang)); F128S[i] = f2bf(-sinpif(ang)); }
    for (int i = gw * 64 + lane; i < 3 * 64 * 72; i += NGW * 64) { const int tb = i / (64 * 72), k2 = (i / 72) % 64, sl = i % 72; float v = 0.f;
        if (sl < 64) { const int q4 = sl >> 4, hh = (sl >> 3) & 1, e = sl & 7, n2 = 16 * q4 + 8 * (e >> 2) + 4 * hh + (e & 3); const float ang = (float)((k2 * n2) & 63) * (1.f / 32.f);
            v = tb == 0 ? cospif(ang) : (tb == 1 ? sinpif(ang) : -sinpif(ang)); }
        F64T[i] = f2bf(v); }
    float* rp = (float*)(ws + T_RPB);
    for (int i = gw * 64 + lane; i < NH * 15 * 31; i += NGW * 64) rp[i] = p.rpb[i] * LOG2E;
}

template <int nM, int nN, int nt, int lda, int ldb> struct SchedGrid {
    static constexpr bool HAS_KEEP = false;
    const char* A; const char* B; int G, c;
    __device__ __forceinline__ bool next(int i, g8::Unit& u) const {
        const int L = i * G + c; if (L >= nM * nN) return false;
        int pm, pn; g8::tile_of<(nN <= 8 ? 8 : 4)>(L, nM, nN, pm, pn);
        u.pm = pm; u.pn = pn; u.nt = nt; u.keep = 0; u.br = 0;
        u.a = A + (size_t)pm * 256 * lda * 2; u.b = B + (size_t)pn * 256 * ldb * 2; return true;
    }
};
struct EpiChDft {
    bf16_t* Y;
    __device__ __forceinline__ void operator()(f32x4 (&acc)[2][2][4][2], const g8::Unit& u, int wr, int wc, int fr, int fq) const {
        if (u.keep) return;
        asm volatile("" : "+v"(fr), "+v"(fq));
        const int k0 = (u.pm & 15) * 256 + wr * 64 + fr;
        bf16_t* const Yb = Y + (size_t)(u.pm >> 4) * SEQ * FW + (u.pn * 128 + 32 * wc + 8 * fq);
#pragma unroll
        for (int ai = 0; ai < 2; ++ai)
#pragma unroll
            for (int m = 0; m < 4; ++m) { const int k = k0 + ai * 128 + m * 16;
#pragma unroll
                for (int bj = 0; bj < 2; ++bj) { const f32x4 v0 = acc[ai][bj][m][0], v1 = acc[ai][bj][m][1];
                    u32x4 w; w.x = g8::cvt_pk_bf16(v0[0], v0[1]); w.y = g8::cvt_pk_bf16(v0[2], v0[3]); w.z = g8::cvt_pk_bf16(v1[0], v1[1]); w.w = g8::cvt_pk_bf16(v1[2], v1[3]);
                    *(u32x4*)(Yb + (size_t)(bj ? ((SEQ - k) & (SEQ - 1)) : k) * FW) = w; } }
    }
};
struct EpiP1 {
    unsigned char* ws; bf16_t* gates; LAS unsigned char* xtra;
    __device__ __forceinline__ void operator()(f32x4 (&acc)[2][2][4][2], const g8::Unit& u, int wr, int wc, int fr, int fq) const {
        asm volatile("" : "+v"(fr), "+v"(fq));
        bf16_t* const Q = (bf16_t*)(ws + WS_Q); bf16_t* const Kb = (bf16_t*)(ws + WS_K); bf16_t* const V = (bf16_t*)(ws + WS_V); bf16_t* const FT = (bf16_t*)(ws + WS_FT); bf16_t* const SA = gates; bf16_t* const SB = gates + (size_t)M * D;
        const int pn = u.pn, row0 = u.pm * 256 + wr * 64 + fr;
        float rs[2][4];
#pragma unroll
        for (int ai = 0; ai < 2; ++ai)
#pragma unroll
            for (int m = 0; m < 4; ++m) rs[ai][m] = 1.f;
        if (pn < 8) {
            const bool isq = pn < 4; const LAS float* gn = (const LAS float*)(xtra + 16384) + (isq ? 0 : 64); bf16_t* O = isq ? Q : Kb; const int head = (pn & 3) * 4 + wc;
            f32x4 gv[2][2];
#pragma unroll
            for (int bj = 0; bj < 2; ++bj)
#pragma unroll
                for (int n = 0; n < 2; ++n) gv[bj][n] = *(const LAS f32x4*)(gn + 32 * bj + 8 * fq + 4 * n);
#pragma unroll
            for (int ai = 0; ai < 2; ++ai)
#pragma unroll
                for (int m = 0; m < 4; ++m) { const int r = row0 + ai * 128 + m * 16; const float rsv = rs[ai][m]; float ss = 0.f;
#pragma unroll
                    for (int bj = 0; bj < 2; ++bj)
#pragma unroll
                        for (int n = 0; n < 2; ++n) { const f32x4 v = acc[ai][bj][m][n]; ss += (v[0] * v[0] + v[1] * v[1]) + (v[2] * v[2] + v[3] * v[3]); }
                    ss = xsum32(xsum16(ss));
                    const float rn = rsqrtf(ss * rsv * rsv * (1.f / 64.f) + EPS) * rsv * (isq ? QSCALE : 1.f);
#pragma unroll
                    for (int bj = 0; bj < 2; ++bj) { const f32x4 v0 = acc[ai][bj][m][0] * rn * gv[bj][0], v1 = acc[ai][bj][m][1] * rn * gv[bj][1];
                        u32x4 w; w.x = g8::cvt_pk_bf16(v0[0], v0[1]); w.y = g8::cvt_pk_bf16(v0[2], v0[3]); w.z = g8::cvt_pk_bf16(v1[0], v1[1]); w.w = g8::cvt_pk_bf16(v1[2], v1[3]);
                        *(u32x4*)(O + (size_t)r * AW + head * 64 + 32 * bj + 8 * fq) = w; } }
        } else if (pn >= 12 && pn < 16) {
            const int b = (u.pm * 256) / SEQ; bf16_t* Fb = FT + ((size_t)b * FW + (pn - 12) * 256 + wr * 64 + fr) * SEQ + (u.pm * 256 - b * SEQ);
#pragma unroll
            for (int ai = 0; ai < 2; ++ai)
#pragma unroll
                for (int m = 0; m < 4; ++m) { bf16_t* rowp = Fb + (size_t)(ai * 128 + m * 16) * SEQ;
#pragma unroll
                    for (int bj = 0; bj < 2; ++bj) { const f32x4 v0 = acc[ai][bj][m][0], v1 = acc[ai][bj][m][1];
                        u32x4 w; w.x = g8::cvt_pk_bf16(v0[0], v0[1]); w.y = g8::cvt_pk_bf16(v0[2], v0[3]); w.z = g8::cvt_pk_bf16(v1[0], v1[1]); w.w = g8::cvt_pk_bf16(v1[2], v1[3]);
                        *(u32x4*)(rowp + g8::colbase<true>(bj, wc, fq)) = w; } }
        } else if (pn < 12) { store_rows<false>(acc, rs, V, AW, (pn - 8) * 256, row0, wc, fq);
        } else { store_rows<true>(acc, rs, pn < 24 ? SA : SB, D, ((pn - 16) & 7) * 256, row0, wc, fq); }
    }
    template <bool SIG> __device__ __forceinline__ void store_rows(const f32x4 (&acc)[2][2][4][2], const float (&rs)[2][4], bf16_t* O, int ldo, int cb, int row0, int wc, int fq) const {
#pragma unroll
        for (int ai = 0; ai < 2; ++ai)
#pragma unroll
            for (int m = 0; m < 4; ++m) { const int r = row0 + ai * 128 + m * 16; const float rsv = rs[ai][m];
#pragma unroll
                for (int bj = 0; bj < 2; ++bj) { f32x4 v0 = acc[ai][bj][m][0] * rsv, v1 = acc[ai][bj][m][1] * rsv;
                    if (SIG) {
#pragma unroll
                        for (int e = 0; e < 4; ++e) { v0[e] = __builtin_amdgcn_rcpf(1.f + __builtin_amdgcn_exp2f(v0[e])); v1[e] = __builtin_amdgcn_rcpf(1.f + __builtin_amdgcn_exp2f(v1[e])); } }
                    u32x4 w; w.x = g8::cvt_pk_bf16(v0[0], v0[1]); w.y = g8::cvt_pk_bf16(v0[2], v0[3]); w.z = g8::cvt_pk_bf16(v1[0], v1[1]); w.w = g8::cvt_pk_bf16(v1[2], v1[3]);
                    *(u32x4*)(O + (size_t)r * ldo + cb + g8::colbase<true>(bj, wc, fq)) = w; }
                __builtin_amdgcn_sched_barrier(0); }
    }
};

struct SchedP1 {
    static constexpr bool HAS_KEEP = false;
    const char* XB; const char* W; int G, c;
    __device__ __forceinline__ bool next(int i, g8::Unit& u) const {
        const int L = i * G + c; if (L >= (M / 256) * (INW / 256)) return false;
        int pm, pn; g8::tile_of<4>(L, M / 256, INW / 256, pm, pn);
        u.pm = pm; u.pn = pn; u.nt = D / 64; u.keep = 0; u.br = 0;
        const char* xa = XB + (size_t)pm * 256 * D * 2; const char* wb = W + (size_t)pn * 256 * D * 2; const bool sw = pn >= 12 && pn < 16;
        u.a = sw ? wb : xa; u.b = sw ? xa : wb; return true;
    }
};
struct SchedChDft {
    static constexpr bool HAS_KEEP = true;
    const char* PT; const char* TCS; int G, c;
    __device__ __forceinline__ bool next(int i, g8::Unit& u) const {
        const int L = (i >> 1) * G + c; if (L >= 48 * 8) return false;
        int pm, pn; g8::tile_of<8>(L, 48, 8, pm, pn); const int seg = i & 1, g = pn >> 1, h = pn & 1;
        u.pm = pm; u.pn = pn; u.nt = 4; u.keep = seg == 0; u.br = 0;
        u.a = PT + ((size_t)((pm >> 4) * 2 + seg) * FW + g * 256) * SEQ * 2 + (size_t)(pm & 15) * 256 * 2; u.b = TCS + (size_t)h * 256 * 512 * 2 + seg * 256 * 2; return true;
    }
};
struct SchedMerge2 {
    static constexpr bool HAS_KEEP = false;
    const char* Y; const char* ATT; const char* WFO; const char* WAO; int G, c;
    __device__ __forceinline__ bool next(int i, g8::Unit& u) const {
        const int L = (i >> 1) * G + c; if (L >= 96 * 8) return false;
        int pm, pn; g8::tile_of<8>(L, 96, 8, pm, pn); const int br = i & 1;
        u.pm = pm; u.pn = pn; u.nt = 16; u.keep = 0; u.br = br;
        u.a = (br ? ATT : Y) + (size_t)pm * 256 * 1024 * 2; u.b = (br ? WAO : WFO) + (size_t)pn * 256 * 1024 * 2; return true;
    }
};
__device__ __forceinline__ f32x4 bf_lo4(const u32x4 w, int half) { return half == 0 ? (f32x4){__uint_as_float(w[0] << 16), __uint_as_float(w[0] & 0xffff0000u), __uint_as_float(w[1] << 16), __uint_as_float(w[1] & 0xffff0000u)}
                                                                                       : (f32x4){__uint_as_float(w[2] << 16), __uint_as_float(w[2] & 0xffff0000u), __uint_as_float(w[3] << 16), __uint_as_float(w[3] & 0xffff0000u)}; }
__device__ __forceinline__ u32x4 pack8(const f32x4 v0, const f32x4 v1) { u32x4 w; w.x = g8::cvt_pk_bf16(v0[0], v0[1]); w.y = g8::cvt_pk_bf16(v0[2], v0[3]); w.z = g8::cvt_pk_bf16(v1[0], v1[1]); w.w = g8::cvt_pk_bf16(v1[2], v1[3]); return w; }
struct EpiMerge {
    unsigned char* ws; const bf16_t* gates;
    template <bool SECOND> __device__ __forceinline__ void run(f32x4 (&acc)[2][2][4][2], const g8::Unit& u, int wr, int wc, int fr, int fq) const {
        asm volatile("" : "+v"(fr), "+v"(fq));
        bf16_t* const MG = (bf16_t*)(ws + WS_MERGED); const bf16_t* const SA = gates; const bf16_t* const SB = gates + (size_t)M * D;
        const char* S = (const char*)(SECOND ? SB : SA); char* const MGb = (char*)MG;
        unsigned o0 = ((unsigned)(u.pm * 256 + wr * 64 + fr) * D + u.pn * 256 + g8::colbase<false>(0, wc, fq)) * 2u;
#define MRG_LD(d_, off_, base_) asm volatile("global_load_dwordx4 %0, %1, %2" : "=v"(d_) : "v"(off_), "s"(base_) : "memory")
#define MRG_OFF(ai_, m_, bj_) (o0 + (unsigned)((((ai_) * 128 + (m_) * 16) * D + (bj_) * 128) * 2))
        u32x4 ow[2][4][2];
        if constexpr (!SECOND) {
            u32x4 sg[2][4][2];
#pragma unroll
            for (int ai = 0; ai < 2; ++ai)
#pragma unroll
                for (int m = 0; m < 4; ++m)
#pragma unroll
                    for (int bj = 0; bj < 2; ++bj) { const unsigned o = MRG_OFF(ai, m, bj); MRG_LD(sg[ai][m][bj], o, S); }
#define MRG_ST0(ai_, m_, W_) do { asm volatile(W_ : "+v"(sg[ai_][m_][0]), "+v"(sg[ai_][m_][1]) :: "memory"); \
                _Pragma("unroll") for (int bj = 0; bj < 2; ++bj) ow[ai_][m_][bj] = pack8(bf_lo4(sg[ai_][m_][bj], 0) * acc[ai_][bj][m_][0], bf_lo4(sg[ai_][m_][bj], 1) * acc[ai_][bj][m_][1]); __builtin_amdgcn_sched_barrier(0); } while (0)
            MRG_ST0(0, 0, "s_waitcnt vmcnt(14)"); MRG_ST0(0, 1, "s_waitcnt vmcnt(12)"); MRG_ST0(0, 2, "s_waitcnt vmcnt(10)"); MRG_ST0(0, 3, "s_waitcnt vmcnt(8)");
            MRG_ST0(1, 0, "s_waitcnt vmcnt(6)"); MRG_ST0(1, 1, "s_waitcnt vmcnt(4)"); MRG_ST0(1, 2, "s_waitcnt vmcnt(2)"); MRG_ST0(1, 3, "s_waitcnt vmcnt(0)");
#undef MRG_ST0
        } else {
#pragma unroll
            for (int ai = 0; ai < 2; ++ai) {
                u32x4 sg[4][2], pv[4][2];
#pragma unroll
                for (int m = 0; m < 4; ++m)
#pragma unroll
                    for (int bj = 0; bj < 2; ++bj) { const unsigned o = MRG_OFF(ai, m, bj); MRG_LD(sg[m][bj], o, S); MRG_LD(pv[m][bj], o, MGb); }
#define MRG_ST1(m_, W_) do { asm volatile(W_ : "+v"(sg[m_][0]), "+v"(sg[m_][1]), "+v"(pv[m_][0]), "+v"(pv[m_][1]) :: "memory"); \
                _Pragma("unroll") for (int bj = 0; bj < 2; ++bj) ow[ai][m_][bj] = pack8(bf_lo4(sg[m_][bj], 0) * acc[ai][bj][m_][0] + bf_lo4(pv[m_][bj], 0), bf_lo4(sg[m_][bj], 1) * acc[ai][bj][m_][1] + bf_lo4(pv[m_][bj], 1)); __builtin_amdgcn_sched_barrier(0); } while (0)
                MRG_ST1(0, "s_waitcnt vmcnt(12)"); MRG_ST1(1, "s_waitcnt vmcnt(8)"); MRG_ST1(2, "s_waitcnt vmcnt(4)"); MRG_ST1(3, "s_waitcnt vmcnt(0)");
#undef MRG_ST1
            }
        }
#undef MRG_LD
#undef MRG_OFF
#pragma unroll
        for (int ai = 0; ai < 2; ++ai)
#pragma unroll
            for (int m = 0; m < 4; ++m)
#pragma unroll
                for (int bj = 0; bj < 2; ++bj) *(u32x4*)(MGb + (o0 + (unsigned)(((ai * 128 + m * 16) * D + bj * 128) * 2))) = ow[ai][m][bj];
    }
};
struct EpiMergeBr { EpiMerge e;
    __device__ __forceinline__ void operator()(f32x4 (&acc)[2][2][4][2], const g8::Unit& u, int wr, int wc, int fr, int fq) const { if (u.br) e.template run<true>(acc, u, wr, wc, fr, fq); else e.template run<false>(acc, u, wr, wc, fr, fq); } };
struct EpiX1 {
    XIn x; unsigned char* ws;
    __device__ __forceinline__ void operator()(f32x4 (&acc)[2][2][4][2], const g8::Unit& u, int wr, int wc, int fr, int fq) const {
        asm volatile("" : "+v"(fr), "+v"(fq));
        bf16_t* const X1B = (bf16_t*)(ws + WS_X1B); float* const SSQ = (float*)(ws + WS_SSQ);
        const int row0 = u.pm * 256 + wr * 64 + fr; const char* xbase = (const char*)((u.pm < SEQ / 256) ? x.xp : x.xs - (size_t)SEQ * D);
        const unsigned e0 = (unsigned)row0 * D + u.pn * 256 + g8::colbase<false>(0, wc, fq);
        u32x4 ow[2][4][2]; float ssr[2][4]; unsigned tok = 0;
#pragma unroll
        for (int ai = 0; ai < 2; ++ai) {
#pragma unroll
            for (int m = 0; m < 4; ++m) { const unsigned er = e0 + tok + (unsigned)((ai * 128 + m * 16) * D); float ss = 0.f;
#pragma unroll
                for (int bj = 0; bj < 2; ++bj) { const char* xr = xbase + (er + bj * 128) * 4u;
                    const f32x4 v0 = acc[ai][bj][m][0] + *(const f32x4*)xr, v1 = acc[ai][bj][m][1] + *(const f32x4*)(xr + 16);
                    ss += (v0[0] * v0[0] + v0[1] * v0[1]) + (v0[2] * v0[2] + v0[3] * v0[3]) + (v1[0] * v1[0] + v1[1] * v1[1]) + (v1[2] * v1[2] + v1[3] * v1[3]);
                    ow[ai][m][bj] = pack8(v0, v1); }
                if (m == 3) asm volatile("" : "+v"(tok), "+v"(ss));
                ssr[ai][m] = ss; } }
        asm volatile("" ::: "memory");
#pragma unroll
        for (int ai = 0; ai < 2; ++ai)
#pragma unroll
            for (int m = 0; m < 4; ++m) { const int r = row0 + ai * 128 + m * 16;
#pragma unroll
                for (int bj = 0; bj < 2; ++bj) *(u32x4*)((char*)X1B + (e0 + (unsigned)((ai * 128 + m * 16) * D + bj * 128)) * 2u) = ow[ai][m][bj];
                float ss = ssr[ai][m]; ss = xsum32(xsum16(ss));
                if (fq == 0) *(float*)((char*)SSQ + ((unsigned)r * 32u + u.pn * 4 + wc) * 4u) = ss; }
    }
};
__device__ __forceinline__ size_t tmp_base(int pm) { return pm < 48 ? WS_TMP0 : (WS_TMP1 - (size_t)48 * MiB); }
struct EpiTmp {
    unsigned char* ws;
    __device__ __forceinline__ void operator()(f32x4 (&acc)[2][2][4][2], const g8::Unit& u, int wr, int wc, int fr, int fq) const {
        asm volatile("" : "+v"(fr), "+v"(fq));
        const int row0 = u.pm * 256 + wr * 64 + fr; bf16_t* T = (bf16_t*)(ws + tmp_base(u.pm));
#pragma unroll
        for (int ai = 0; ai < 2; ++ai)
#pragma unroll
            for (int m = 0; m < 4; ++m) { bf16_t* rowp = T + (size_t)(row0 + ai * 128 + m * 16) * D + (u.pn * 256);
#pragma unroll
                for (int bj = 0; bj < 2; ++bj) { const f32x4 v0 = acc[ai][bj][m][0], v1 = acc[ai][bj][m][1];
                    u32x4 w; w.x = g8::cvt_pk_bf16(v0[0], v0[1]); w.y = g8::cvt_pk_bf16(v0[2], v0[3]); w.z = g8::cvt_pk_bf16(v1[0], v1[1]); w.w = g8::cvt_pk_bf16(v1[2], v1[3]);
                    *(u32x4*)(rowp + g8::colbase<false>(bj, wc, fq)) = w; } }
    }
};
struct EpiOut {
    float* out; const unsigned char* ws;
    __device__ __forceinline__ void operator()(f32x4 (&acc)[2][2][4][2], const g8::Unit& u, int wr, int wc, int fr, int fq) const {
        asm volatile("" : "+v"(fr), "+v"(fq));
        const bf16_t* const X1B = (const bf16_t*)(ws + WS_X1B); const float* const r2 = (const float*)(ws + T_RSTD2);
        const int row0 = u.pm * 256 + wr * 64 + fr; const bf16_t* T = (const bf16_t*)(ws + tmp_base(u.pm));
#pragma unroll
        for (int ai = 0; ai < 2; ++ai) {
#pragma unroll
            for (int m = 0; m < 4; ++m) { const int r = row0 + ai * 128 + m * 16; const float sc = r2[r]; const size_t ro = (size_t)r * D + (u.pn * 256);
#pragma unroll
                for (int bj = 0; bj < 2; ++bj) { const size_t o = ro + g8::colbase<false>(bj, wc, fq);
                    const u32x4 tv = *(const u32x4*)(T + o), xv = *(const u32x4*)(X1B + o);
                    const f32x4 r0 = bf_lo4(xv, 0) + (bf_lo4(tv, 0) + acc[ai][bj][m][0]) * sc, r1 = bf_lo4(xv, 1) + (bf_lo4(tv, 1) + acc[ai][bj][m][1]) * sc;
                    acc[ai][bj][m][0] = r0; acc[ai][bj][m][1] = r1; } }
            asm volatile("" ::: "memory"); }
#pragma unroll
        for (int ai = 0; ai < 2; ++ai)
#pragma unroll
            for (int m = 0; m < 4; ++m) { float* rowp = out + (size_t)(row0 + ai * 128 + m * 16) * D + (u.pn * 256);
#pragma unroll
                for (int bj = 0; bj < 2; ++bj) { const int cb = g8::colbase<false>(bj, wc, fq);
                    *(f32x4*)(rowp + cb) = acc[ai][bj][m][0]; *(f32x4*)(rowp + cb + 4) = acc[ai][bj][m][1]; } }
    }
};
__device__ __forceinline__ float relu_i(float x) { const int i = __builtin_bit_cast(int, x); return __builtin_bit_cast(float, i > 0 ? i : 0); }
struct EpiRelu2 {
    bf16_t* Ua; bf16_t* Ub;
    __device__ __forceinline__ void operator()(f32x4 (&acc)[2][2][4][2], const g8::Unit& u, int wr, int wc, int fr, int fq) const {
        asm volatile("" : "+v"(fr), "+v"(fq));
        const int row0 = u.pm * 256 + wr * 64 + fr; bf16_t* const U = (u.pn < 16) ? Ua : Ub; const int cb0 = (u.pn & 15) * 256;
#pragma unroll
        for (int ai = 0; ai < 2; ++ai)
#pragma unroll
            for (int m = 0; m < 4; ++m) { bf16_t* rowp = U + (size_t)(row0 + ai * 128 + m * 16) * 4096 + cb0;
#pragma unroll
                for (int bj = 0; bj < 2; ++bj) { f32x4 v0 = acc[ai][bj][m][0], v1 = acc[ai][bj][m][1];
#pragma unroll
                    for (int e = 0; e < 4; ++e) { const float a = relu_i(v0[e]), b = relu_i(v1[e]); v0[e] = a * a; v1[e] = b * b; }
                    u32x4 w; w.x = g8::cvt_pk_bf16(v0[0], v0[1]); w.y = g8::cvt_pk_bf16(v0[2], v0[3]); w.z = g8::cvt_pk_bf16(v1[0], v1[1]); w.w = g8::cvt_pk_bf16(v1[2], v1[3]);
                    *(u32x4*)(rowp + g8::colbase<false>(bj, wc, fq)) = w; }
                __builtin_amdgcn_sched_barrier(0); }
    }
};
struct SchedDown {
    static constexpr bool HAS_KEEP = true;
    const char* Ua; const char* Ub; const char* W2; int G, c;
    __device__ __forceinline__ bool next(int i, g8::Unit& u) const {
        const int L = (i >> 1) * G + c; if (L >= 96 * 8) return false;
        int pm, pn; g8::tile_of<4>(L, 96, 8, pm, pn); const int seg = i & 1;
        u.pm = pm; u.pn = pn; u.nt = 64; u.keep = seg == 0; u.br = 0;
        u.a = (seg ? Ua : Ub) + (size_t)pm * 256 * 4096 * 2; u.b = W2 + ((size_t)pn * 256 * DFF + (seg ? 0 : 4096)) * 2; return true;
    }
};
struct EpiDown {
    float* out; const unsigned char* ws; unsigned* pcnt;
    __device__ __forceinline__ void operator()(f32x4 (&acc)[2][2][4][2], const g8::Unit& u, int wr, int wc, int fr, int fq) const {
        const bool t0 = (wr == 0) && (wc == 0) && (fr == 0) && (fq == 0);
        unsigned* cnt = pcnt + 16 * u.pm;
        if (u.keep) {
            if (t0) __hip_atomic_fetch_add(cnt, 1u, __ATOMIC_RELAXED, __HIP_MEMORY_SCOPE_AGENT);
            return; }
        if (t0) { unsigned sp = 0; while (__hip_atomic_load(cnt, __ATOMIC_RELAXED, __HIP_MEMORY_SCOPE_AGENT) < 8u && ++sp < (1u << 16)) __builtin_amdgcn_s_sleep(2); }
        __builtin_amdgcn_s_barrier();
        asm volatile("" : "+v"(fr), "+v"(fq));
        const bf16_t* const X1B = (const bf16_t*)(ws + WS_X1B); const float* const r2 = (const float*)(ws + T_RSTD2);
        const int row0 = u.pm * 256 + wr * 64 + fr;
        const unsigned e0 = (unsigned)row0 * D + u.pn * 256 + g8::colbase<false>(0, wc, fq);
#pragma unroll
        for (int ai = 0; ai < 2; ++ai) {
            u32x4 xv[4][2]; float scv[4];
#pragma unroll
            for (int m = 0; m < 4; ++m) { const float sc = *(const float*)((const char*)r2 + (unsigned)(row0 + ai * 128 + m * 16) * 4u);
#pragma unroll
                for (int bj = 0; bj < 2; ++bj) xv[m][bj] = *(const u32x4*)((const char*)X1B + (e0 + (unsigned)((ai * 128 + m * 16) * D + bj * 128)) * 2u);
                scv[m] = sc; }
            asm volatile("" : "+v"(xv[0][0]), "+v"(xv[0][1]), "+v"(xv[1][0]), "+v"(xv[1][1]), "+v"(xv[2][0]), "+v"(xv[2][1]), "+v"(xv[3][0]), "+v"(xv[3][1]));
#pragma unroll
            for (int m = 0; m < 4; ++m) {
#pragma unroll
                for (int bj = 0; bj < 2; ++bj) { char* op = (char*)out + (e0 + (unsigned)((ai * 128 + m * 16) * D + bj * 128)) * 4u;
                    const f32x4 r0 = bf_lo4(xv[m][bj], 0) + acc[ai][bj][m][0] * scv[m], r1 = bf_lo4(xv[m][bj], 1) + acc[ai][bj][m][1] * scv[m];
                    *(f32x4*)op = r0; *(f32x4*)(op + 16) = r1; }
                __builtin_amdgcn_sched_barrier(0); }
            asm volatile("" ::: "memory"); }
    }
};
typedef short v4i16_t __attribute__((ext_vector_type(4)));
__device__ __forceinline__ void natten_phase(const Params& p, LAS unsigned char* lds, int G, int bx, int tid, int lane, int wave) {
    unsigned char* ws = p.ws;
    const bf16_t* Qg = (const bf16_t*)(ws + WS_Q); const bf16_t* Kg = (const bf16_t*)(ws + WS_K); const bf16_t* Vg = (const bf16_t*)(ws + WS_V); bf16_t* ATT = (bf16_t*)(ws + WS_ATT);
    const float* rp = (const float*)(ws + T_RPB);
    LAS float* biasT = (LAS float*)(lds + XTRA_OFF);
    const int j = lane & 15, q = lane >> 4, qq = j >> 2, pp = j & 3;
    constexpr int QOFF = XTRA_OFF + 4096;
    const int wv = __builtin_amdgcn_readfirstlane(wave);
    const int keyl = (wv & 3) * 8 + (lane >> 3), pch = lane & 7;
    const unsigned voK = (unsigned)(keyl * AW + ((pch ^ ((keyl >> 1) & 7)) << 3)) * 2u, voV = (unsigned)(keyl * AW + ((pch ^ (2 * ((keyl >> 1) & 3))) << 3)) * 2u;
    const unsigned voQ = (unsigned)((lane >> 3) * AW + pch * 8) * 2u, voB = (unsigned)lane * 4u;
#define NAT_PIECE(sb_expr_, vo_, ldsoff_, sz_) do { const char* sb_ = (sb_expr_); asm volatile("" : "+s"(sb_)); unsigned vv_ = (vo_); asm volatile("" : "+v"(vv_)); \
        __builtin_amdgcn_global_load_lds((const unsigned*)(sb_ + vv_), (LAS unsigned*)(lds + (ldsoff_)), sz_, 0, 0); } while (0)
#define NAT_DMA_KV(it2_, gbase_, ldsoff_, vo_) do { const int g2 = (it2_) & 3, rb2 = ((it2_) >> 2) & 15, h2 = ((it2_) >> 6) & 15, b2 = (it2_) >> 10; \
        const int base2 = min(max(8 * rb2 - 4, 0), 112), kcb2 = (g2 == 0) ? 0 : (g2 == 1) ? 8 : (g2 == 2) ? 24 : 32; \
        const char* sb0_ = (const char*)(gbase_) + (size_t)((((unsigned)b2 * SEQ + (base2 + (wv >> 2)) * 64 + kcb2) * AW + h2 * HD) * 2u); \
        _Pragma("unroll") for (int jj = 0; jj < 8; ++jj) NAT_PIECE(sb0_ + jj * 262144, vo_, (ldsoff_) + 8192 * jj + 1024 * wv, 16); } while (0)
#define NAT_DMA_QB(it2_) do { const int g2 = (it2_) & 3, rb2 = ((it2_) >> 2) & 15, h2 = ((it2_) >> 6) & 15, b2 = (it2_) >> 10; \
        const char* sq_ = (const char*)Qg + (size_t)((((unsigned)b2 * SEQ + (8 * rb2 + wv) * 64 + 16 * g2) * AW + h2 * HD) * 2u); \
        NAT_PIECE(sq_, voQ, QOFF + 2048 * wv, 16); NAT_PIECE(sq_ + 8 * AW * 2, voQ, QOFF + 2048 * wv + 1024, 16); \
        NAT_PIECE((const char*)rp + (size_t)((h2 * 465 + 64 * wv) * 4), voB, XTRA_OFF + 256 + 256 * wv, 4); } while (0)
    if (bx < 3072) { NAT_DMA_QB(bx); NAT_DMA_KV(bx, Kg, 0, voK); asm volatile("s_waitcnt vmcnt(0)" ::: "memory"); NAT_DMA_KV(bx, Vg, 65536, voV); }
    for (int it = bx; it < 3072; it += G) {
        const int g = it & 3, rb = (it >> 2) & 15, h = (it >> 6) & 15, b = it >> 10;
        const int base = min(max(8 * rb - 4, 0), 112), kcb = (g == 0) ? 0 : (g == 1) ? 8 : (g == 2) ? 24 : 32;
        const int itn = (it + G < 3072) ? it + G : it;
        asm volatile("s_waitcnt vmcnt(10)" ::: "memory");
        __builtin_amdgcn_s_barrier(); asm volatile("" ::: "memory");
        const int r = 8 * rb + wave, rs = min(max(r - 4, 0), 120), s0 = rs - base, c = 16 * g + j, cs = min(max(c - 8, 0), 48);
        bool sel[4]; int bix[4];
#pragma unroll
        for (int e = 0; e < 4; ++e) { const int kc0 = kcb + 4 * q + e; sel[e] = kc0 >= cs; bix[e] = 64 + (rs - r + 7) * 31 + 15 - c + kc0 + (sel[e] ? 0 : 16); }
        const unsigned m01 = (sel[0] ? 0xFFFFu : 0u) | (sel[1] ? 0xFFFF0000u : 0u), m23 = (sel[2] ? 0xFFFFu : 0u) | (sel[3] ? 0xFFFF0000u : 0u);
#define NAT_RD128(d_, a_, off_) asm volatile("ds_read_b128 %0, %1 offset:%2" : "=v"(d_) : "v"(a_), "n"(off_) : "memory")
#define NAT_RD32(d_, a_, off_) asm volatile("ds_read_b32 %0, %1 offset:%2" : "=v"(d_) : "v"(a_), "n"(off_) : "memory")
        const unsigned lb_ = (unsigned)(size_t)lds;
        unsigned kb_[2][2], bb_[4];
#pragma unroll
        for (int hf = 0; hf < 2; ++hf) { const int key = 16 * hf + j, ka = (s0 * 32 + key) * 128, sw = (key >> 1) & 7; kb_[hf][0] = lb_ + ka + ((q ^ sw) << 4); kb_[hf][1] = lb_ + ka + (((4 + q) ^ sw) << 4); }
#pragma unroll
        for (int e = 0; e < 4; ++e) bb_[e] = lb_ + XTRA_OFF + 4 * bix[e];
        bf16x8 qf0, qf1; { const unsigned qa_ = lb_ + QOFF + 2048 * wv + j * 128 + q * 16; NAT_RD128(qf0, qa_, 0); NAT_RD128(qf1, qa_, 64); }
        f32x4 S[8][2];
        bf16x8 kf[2][2][2]; float bz[2][4];
#define NAT_READS(bf_, a_) do { \
            NAT_RD128(kf[bf_][0][0], kb_[0][0], (a_) * 4096); NAT_RD128(kf[bf_][0][1], kb_[0][1], (a_) * 4096); NAT_RD128(kf[bf_][1][0], kb_[1][0], (a_) * 4096); NAT_RD128(kf[bf_][1][1], kb_[1][1], (a_) * 4096); \
            NAT_RD32(bz[bf_][0], bb_[0], (a_) * 124); NAT_RD32(bz[bf_][1], bb_[1], (a_) * 124); NAT_RD32(bz[bf_][2], bb_[2], (a_) * 124); NAT_RD32(bz[bf_][3], bb_[3], (a_) * 124); } while (0)
#define NAT_SCORE(bf_, a_, WAITSTR_) do { \
            asm volatile(WAITSTR_ : "+v"(kf[bf_][0][0]), "+v"(kf[bf_][0][1]), "+v"(kf[bf_][1][0]), "+v"(kf[bf_][1][1]), "+v"(bz[bf_][0]), "+v"(bz[bf_][1]), "+v"(bz[bf_][2]), "+v"(bz[bf_][3]), "+v"(qf0), "+v"(qf1) :: "memory"); \
            { const f32x4 bzv = {bz[bf_][0], bz[bf_][1], bz[bf_][2], bz[bf_][3]}; \
                _Pragma("unroll") for (int hf = 0; hf < 2; ++hf) { f32x4 z = __builtin_amdgcn_mfma_f32_16x16x32_bf16(kf[bf_][hf][0], qf0, bzv, 0, 0, 0); \
                    S[a_][hf] = __builtin_amdgcn_mfma_f32_16x16x32_bf16(kf[bf_][hf][1], qf1, z, 0, 0, 0); } } } while (0)
        NAT_READS(0, 0);
        NAT_READS(1, 1); NAT_SCORE(0, 0, "s_waitcnt lgkmcnt(8)"); NAT_READS(0, 2); NAT_SCORE(1, 1, "s_waitcnt lgkmcnt(8)"); NAT_READS(1, 3); NAT_SCORE(0, 2, "s_waitcnt lgkmcnt(8)");
        NAT_READS(0, 4); NAT_SCORE(1, 3, "s_waitcnt lgkmcnt(8)"); NAT_READS(1, 5); NAT_SCORE(0, 4, "s_waitcnt lgkmcnt(8)"); NAT_READS(0, 6); NAT_SCORE(1, 5, "s_waitcnt lgkmcnt(8)");
        NAT_READS(1, 7); NAT_SCORE(0, 6, "s_waitcnt lgkmcnt(8)"); NAT_SCORE(1, 7, "s_waitcnt lgkmcnt(0)");
#undef NAT_READS
#undef NAT_SCORE
#undef NAT_RD128
#undef NAT_RD32
        asm volatile("s_waitcnt vmcnt(0)" ::: "memory");
        __builtin_amdgcn_s_barrier(); asm volatile("" ::: "memory");
        NAT_DMA_QB(itn); NAT_DMA_KV(itn, Kg, 0, voK);
        f32x4 Sf[8]; float mx = -INFINITY;
#pragma unroll
        for (int a = 0; a < 8; ++a)
#pragma unroll
            for (int e = 0; e < 4; ++e) { const float sv = sel[e] ? S[a][0][e] : S[a][1][e]; Sf[a][e] = sv; mx = fmaxf(mx, sv); }
        mx = xmax32(xmax16(mx));
        float l = 0.f;
#pragma unroll
        for (int a = 0; a < 8; ++a)
#pragma unroll
            for (int e = 0; e < 4; ++e) { const float pv = __builtin_amdgcn_exp2f(Sf[a][e] - mx); Sf[a][e] = pv; l += pv; }
        l = xsum32(xsum16(l));
        f32x4 O[4];
#pragma unroll
        for (int dt = 0; dt < 4; ++dt) O[dt] = (f32x4){0.f, 0.f, 0.f, 0.f};
        unsigned vb_[4][2];
#pragma unroll
        for (int dt = 0; dt < 4; ++dt) { const int kk0 = 4 * q + qq, kk1 = 16 + 4 * q + qq, chunk = 2 * dt + (pp >> 1);
            vb_[dt][0] = (unsigned)(size_t)lds + 65536 + (s0 * 32 + kk0) * 128 + ((chunk ^ (2 * ((kk0 >> 1) & 3))) << 4) + (pp & 1) * 8;
            vb_[dt][1] = (unsigned)(size_t)lds + 65536 + (s0 * 32 + kk1) * 128 + ((chunk ^ (2 * ((kk1 >> 1) & 3))) << 4) + (pp & 1) * 8; }
        asm volatile("" : "+v"(vb_[0][0]), "+v"(vb_[0][1]), "+v"(vb_[1][0]), "+v"(vb_[1][1]), "+v"(vb_[2][0]), "+v"(vb_[2][1]), "+v"(vb_[3][0]), "+v"(vb_[3][1]));
#define NAT_TR(d_, a_, off_) asm volatile("ds_read_b64_tr_b16 %0, %1 offset:%2" : "=v"(d_) : "v"(a_), "n"(off_) : "memory")
        v4i16_t lo[2][4], hi[2][4];
#define NAT_READV(bf_, a_) do { NAT_TR(lo[bf_][0], vb_[0][0], (a_) * 4096); NAT_TR(hi[bf_][0], vb_[0][1], (a_) * 4096); NAT_TR(lo[bf_][1], vb_[1][0], (a_) * 4096); NAT_TR(hi[bf_][1], vb_[1][1], (a_) * 4096); \
            NAT_TR(lo[bf_][2], vb_[2][0], (a_) * 4096); NAT_TR(hi[bf_][2], vb_[2][1], (a_) * 4096); NAT_TR(lo[bf_][3], vb_[3][0], (a_) * 4096); NAT_TR(hi[bf_][3], vb_[3][1], (a_) * 4096); } while (0)
#define NAT_PV_ROW(a_, bf_, WAITSTR_) do { const unsigned p01 = g8::cvt_pk_bf16(Sf[a_][0], Sf[a_][1]), p23 = g8::cvt_pk_bf16(Sf[a_][2], Sf[a_][3]); \
            u32x4 pw; pw.x = p01 & m01; pw.y = p23 & m23; pw.z = p01 & ~m01; pw.w = p23 & ~m23; const bf16x8 pf = __builtin_bit_cast(bf16x8, pw); \
            asm volatile(WAITSTR_ : "+v"(lo[bf_][0]), "+v"(hi[bf_][0]), "+v"(lo[bf_][1]), "+v"(hi[bf_][1]), "+v"(lo[bf_][2]), "+v"(hi[bf_][2]), "+v"(lo[bf_][3]), "+v"(hi[bf_][3]) :: "memory"); \
            _Pragma("unroll") for (int dt = 0; dt < 4; ++dt) { const bf16x8 vf = (bf16x8){lo[bf_][dt][0], lo[bf_][dt][1], lo[bf_][dt][2], lo[bf_][dt][3], hi[bf_][dt][0], hi[bf_][dt][1], hi[bf_][dt][2], hi[bf_][dt][3]}; \
                O[dt] = __builtin_amdgcn_mfma_f32_16x16x32_bf16(vf, pf, O[dt], 0, 0, 0); } } while (0)
        NAT_READV(0, 0);
        NAT_READV(1, 1); NAT_PV_ROW(0, 0, "s_waitcnt lgkmcnt(8)"); NAT_READV(0, 2); NAT_PV_ROW(1, 1, "s_waitcnt lgkmcnt(8)"); NAT_READV(1, 3); NAT_PV_ROW(2, 0, "s_waitcnt lgkmcnt(8)");
        NAT_READV(0, 4); NAT_PV_ROW(3, 1, "s_waitcnt lgkmcnt(8)"); NAT_READV(1, 5); NAT_PV_ROW(4, 0, "s_waitcnt lgkmcnt(8)"); NAT_READV(0, 6); NAT_PV_ROW(5, 1, "s_waitcnt lgkmcnt(8)");
        NAT_READV(1, 7); NAT_PV_ROW(6, 0, "s_waitcnt lgkmcnt(8)"); NAT_PV_ROW(7, 1, "s_waitcnt lgkmcnt(0)");
#undef NAT_READV
#undef NAT_PV_ROW
#undef NAT_TR
        asm volatile("" ::: "memory"); __builtin_amdgcn_s_barrier(); asm volatile("" ::: "memory");
        const float il = __builtin_amdgcn_rcpf(l);
        bf16_t* op = ATT + ((size_t)b * SEQ + r * 64 + c) * ATT_LD + h * HD + 4 * q + ((q & 1) ? 12 : 0);
#pragma unroll
        for (int pr2 = 0; pr2 < 2; ++pr2) { const f32x4 o0 = O[2 * pr2] * il, o1 = O[2 * pr2 + 1] * il;
            const auto rx = __builtin_amdgcn_permlane16_swap(g8::cvt_pk_bf16(o0[0], o0[1]), g8::cvt_pk_bf16(o1[0], o1[1]), false, false);
            const auto ry = __builtin_amdgcn_permlane16_swap(g8::cvt_pk_bf16(o0[2], o0[3]), g8::cvt_pk_bf16(o1[2], o1[3]), false, false);
            u32x4 w; w.x = rx[0]; w.y = ry[0]; w.z = rx[1]; w.w = ry[1]; *(u32x4*)(op + 32 * pr2) = w; }
        NAT_DMA_KV(itn, Vg, 65536, voV);
    }
#undef NAT_DMA_KV
#undef NAT_DMA_QB
#undef NAT_PIECE
    asm volatile("s_waitcnt vmcnt(0)" ::: "memory");
    __syncthreads();
}

__device__ __forceinline__ int crow32(int g, int h) { return (g & 3) + 8 * (g >> 2) + 4 * h; }
__device__ __forceinline__ void fft_phase(const Params& p, LAS unsigned char* lds, int G, int bx, int tid, int lane, int wave) {
    unsigned char* ws = p.ws;
    const bf16_t* FT = (const bf16_t*)(ws + WS_FT); bf16_t* PT = (bf16_t*)(ws + WS_PT);
    const int r = lane & 31, h = lane >> 5, kb = wave & 3, chw = wave >> 2, li = lane & 15, qq = li >> 2, pp = li & 3, colhalf = (lane >> 4) & 1;
    LAS unsigned char* tbl = lds + XTRA_OFF + 4096;
    for (int i = tid; i < 27648 / 16; i += NTHR) *(LAS u32x4*)(tbl + 16 * i) = *(const u32x4*)(ws + T_F64 + 16 * i);
    bf16x8 Bc[8], Bs[8];
    { const bf16_t* fc = (const bf16_t*)(ws + T_F128C) + (32 * kb + r) * 128 + 8 * h; const bf16_t* fs = (const bf16_t*)(ws + T_F128S) + (32 * kb + r) * 128 + 8 * h;
#pragma unroll
      for (int ks = 0; ks < 8; ++ks) { Bc[ks] = *(const bf16x8*)(fc + 16 * ks); Bs[ks] = *(const bf16x8*)(fs + 16 * ks); } }
    unsigned twp[2][16];
#pragma unroll
    for (int mt = 0; mt < 2; ++mt)
#pragma unroll
        for (int g = 0; g < 16; ++g) { const int n2 = 32 * mt + crow32(g, h), k1 = 32 * kb + r; const float x = (float)((n2 * k1) & 8191) * (1.f / 8192.f); twp[mt][g] = g8::cvt_pk_bf16(__builtin_amdgcn_cosf(x), __builtin_amdgcn_sinf(x)); }
    __syncthreads();
    const int sw = ((qq >> 1) & 1) << 2;
    u32x4 v[4];
    auto issue = [&](int it2) { const bf16_t* src2 = FT + ((size_t)((it2 / 512) * FW + 2 * (it2 % 512))) * SEQ;
#pragma unroll
        for (int jj = 0; jj < 4; ++jj) v[jj] = *(const u32x4*)(src2 + (size_t)(tid + NTHR * jj) * 8); };
    if (bx < 1536) issue(bx);
    for (int it = bx; it < 1536; it += G) {
        const int b = it / 512, cp = it % 512, ch = 2 * cp + chw;
        __syncthreads();
#pragma unroll
        for (int jj = 0; jj < 4; ++jj) { const int pid = tid + NTHR * jj, chn = pid >> 10, n1 = (pid >> 3) & 127, c8 = pid & 7;
            *(LAS u32x4*)(lds + chn * 16384 + n1 * 128 + ((c8 ^ (((n1 >> 1) & 1) << 2)) << 4)) = v[jj]; }
        __syncthreads();
        if (it + G < 1536) issue(it + G);
        int frep_ = FFT_REP; asm volatile("" : "+s"(frep_));
        for (int rep_ = 0; rep_ < frep_; ++rep_) {
        f32x16 a1r[2], a1i[2];
#pragma unroll
        for (int mt = 0; mt < 2; ++mt)
#pragma unroll
            for (int g = 0; g < 16; ++g) { a1r[mt][g] = 0.f; a1i[mt][g] = 0.f; }
        {
            unsigned fa_[2];
#pragma unroll
            for (int mt = 0; mt < 2; ++mt) { const int c8 = 4 * mt + 2 * colhalf + (pp >> 1); fa_[mt] = (unsigned)(size_t)lds + chw * 16384 + (8 * h + qq) * 128 + ((c8 ^ sw) << 4) + (pp & 1) * 8; }
            v4i16_t lo[3][2], hi[3][2];
#define FFT_TR(d_, a_, off_) asm volatile("ds_read_b64_tr_b16 %0, %1 offset:%2" : "=v"(d_) : "v"(a_), "n"(off_) : "memory")
#define FFT_RD1(bf_, ks_) do { FFT_TR(lo[bf_][0], fa_[0], (ks_) * 2048); FFT_TR(hi[bf_][0], fa_[0], (ks_) * 2048 + 512); FFT_TR(lo[bf_][1], fa_[1], (ks_) * 2048); FFT_TR(hi[bf_][1], fa_[1], (ks_) * 2048 + 512); } while (0)
#define FFT_ST1(bf_, ks_, WAITSTR_) do { asm volatile(WAITSTR_ : "+v"(lo[bf_][0]), "+v"(hi[bf_][0]), "+v"(lo[bf_][1]), "+v"(hi[bf_][1]) :: "memory"); \
                _Pragma("unroll") for (int mt = 0; mt < 2; ++mt) { const bf16x8 A = (bf16x8){lo[bf_][mt][0], lo[bf_][mt][1], lo[bf_][mt][2], lo[bf_][mt][3], hi[bf_][mt][0], hi[bf_][mt][1], hi[bf_][mt][2], hi[bf_][mt][3]}; \
                    a1r[mt] = __builtin_amdgcn_mfma_f32_32x32x16_bf16(A, Bc[ks_], a1r[mt], 0, 0, 0); a1i[mt] = __builtin_amdgcn_mfma_f32_32x32x16_bf16(A, Bs[ks_], a1i[mt], 0, 0, 0); } } while (0)
            FFT_RD1(0, 0); FFT_RD1(1, 1);
            FFT_RD1(2, 2); FFT_ST1(0, 0, "s_waitcnt lgkmcnt(8)"); FFT_RD1(0, 3); FFT_ST1(1, 1, "s_waitcnt lgkmcnt(8)"); FFT_RD1(1, 4); FFT_ST1(2, 2, "s_waitcnt lgkmcnt(8)");
            FFT_RD1(2, 5); FFT_ST1(0, 3, "s_waitcnt lgkmcnt(8)"); FFT_RD1(0, 6); FFT_ST1(1, 4, "s_waitcnt lgkmcnt(8)"); FFT_RD1(1, 7); FFT_ST1(2, 5, "s_waitcnt lgkmcnt(8)");
            FFT_ST1(0, 6, "s_waitcnt lgkmcnt(4)"); FFT_ST1(1, 7, "s_waitcnt lgkmcnt(0)");
#undef FFT_ST1
#undef FFT_RD1
#undef FFT_TR
        }
        if (kb == 0) {
            float sg = 0.f;
#pragma unroll
            for (int mt = 0; mt < 2; ++mt)
#pragma unroll
                for (int g = 0; g < 16; ++g) sg += (g & 1) ? -a1r[mt][g] : a1r[mt][g];
            sg = xsum32(sg);
            if (lane == 0) ((float*)(ws + T_P4096))[b * FW + ch] = sg;
        }
        bf16x8 Br[2][2], Bi[2][2];
#pragma unroll
        for (int mt = 0; mt < 2; ++mt)
#pragma unroll
            for (int s = 0; s < 2; ++s) { u32x4 wr_, wi_;
#pragma unroll
                for (int e2 = 0; e2 < 4; ++e2) { const int g0 = 8 * s + 2 * e2, g1 = g0 + 1;
                    unsigned w0 = twp[mt][g0], w1 = twp[mt][g1]; asm volatile("" : "+v"(w0), "+v"(w1));
                    const float c0 = __uint_as_float(w0 << 16), s0_ = __uint_as_float(w0 & 0xffff0000u), c1 = __uint_as_float(w1 << 16), s1_ = __uint_as_float(w1 & 0xffff0000u);
                    const float xr0 = a1r[mt][g0] * c0 + a1i[mt][g0] * s0_, xi0 = a1i[mt][g0] * c0 - a1r[mt][g0] * s0_;
                    const float xr1 = a1r[mt][g1] * c1 + a1i[mt][g1] * s1_, xi1 = a1i[mt][g1] * c1 - a1r[mt][g1] * s1_;
                    wr_[e2] = g8::cvt_pk_bf16(xr0, xr1); wi_[e2] = g8::cvt_pk_bf16(xi0, xi1); }
                Br[mt][s] = __builtin_bit_cast(bf16x8, wr_); Bi[mt][s] = __builtin_bit_cast(bf16x8, wi_); }
        LAS unsigned char* stg = lds + 65536 + wave * 8192;
#pragma unroll
        for (int mt2 = 0; mt2 < 1; ++mt2) {
            f32x16 pr, pi;
#pragma unroll
            for (int g = 0; g < 16; ++g) { pr[g] = 0.f; pi[g] = 0.f; }
#pragma unroll
            for (int q4 = 0; q4 < 4; ++q4) { const int off = (32 * mt2 + r) * 144 + (q4 * 16 + 8 * h) * 2;
                bf16x8 Cf = *(const LAS bf16x8*)(tbl + off), Sf = *(const LAS bf16x8*)(tbl + 9216 + off), NSf = *(const LAS bf16x8*)(tbl + 18432 + off);
                asm volatile("" : "+v"(Cf), "+v"(Sf), "+v"(NSf));
                pr = __builtin_amdgcn_mfma_f32_32x32x16_bf16(Cf, Br[q4 >> 1][q4 & 1], pr, 0, 0, 0);
                pr = __builtin_amdgcn_mfma_f32_32x32x16_bf16(Sf, Bi[q4 >> 1][q4 & 1], pr, 0, 0, 0);
                pi = __builtin_amdgcn_mfma_f32_32x32x16_bf16(Cf, Bi[q4 >> 1][q4 & 1], pi, 0, 0, 0);
                pi = __builtin_amdgcn_mfma_f32_32x32x16_bf16(NSf, Br[q4 >> 1][q4 & 1], pi, 0, 0, 0); }
#pragma unroll
            for (int g = 0; g < 16; ++g) { const int row = 32 * mt2 + crow32(g, h);
                *(LAS bf16_t*)(stg + row * 64 + r * 2) = (bf16_t)(g8::cvt_pk_bf16(pr[g], pr[g]) & 0xffffu);
                *(LAS bf16_t*)(stg + 4096 + row * 64 + r * 2) = (bf16_t)(g8::cvt_pk_bf16(pi[g], pi[g]) & 0xffffu); }
        }
#pragma unroll
        for (int part = 0; part < 2; ++part)
#pragma unroll
            for (int st = 0; st < 2; ++st) { const int row = st * 16 + (lane >> 2), c4 = lane & 3;
                const u32x4 w = *(const LAS u32x4*)(stg + part * 4096 + row * 64 + c4 * 16);
                *(u32x4*)(PT + ((size_t)((b * 2 + part) * FW + ch)) * SEQ + 128 * row + 32 * kb + 8 * c4) = w; }
        }
    }
    __syncthreads();
}
__device__ __forceinline__ void ph_inproj(const Params& p, LAS unsigned char* lds, int G, int bx) {
    unsigned char* ws = p.ws;
    { typedef SchedP1 SG; SG S{(const char*)(ws + WS_XB), (const char*)(ws + WS_WIN), G, bx};
      if (threadIdx.x < 128) ((LAS float*)(lds + XTRA_OFF + 16384))[threadIdx.x] = threadIdx.x < 64 ? p.q_norm[threadIdx.x] : p.k_norm[threadIdx.x - 64];
      __syncthreads();
      EpiP1 E{ws, (bf16_t*)p.out, lds + XTRA_OFF};
      g8::gemm_phase<EpiP1, SG, D, D, true, KREP_[1]>(lds, S, E); }
}
__device__ __forceinline__ void ph_chdft(const Params& p, LAS unsigned char* lds, int G, int bx, int tid) {
    unsigned char* ws = p.ws;
    if (bx >= 244) {
        const int j = bx - 244, b = j >> 2, g = j & 3, c8 = tid & 31, cr = tid >> 5;
        const float* P4 = (const float*)(ws + T_P4096) + b * FW + g * 256 + cr * 16; const bf16_t* Tc = (const bf16_t*)(ws + T_DFTC) + (size_t)cr * 16 * 256 + 8 * c8;
        f32x4 s0 = {0.f, 0.f, 0.f, 0.f}, s1 = {0.f, 0.f, 0.f, 0.f};
#pragma unroll
        for (int q = 0; q < 16; ++q) { const float pv = P4[q]; const u32x4 w = *(const u32x4*)(Tc + q * 256); s0 += pv * bf_lo4(w, 0); s1 += pv * bf_lo4(w, 1); }
        LAS float* red = (LAS float*)lds;
        *(LAS f32x4*)(red + cr * 256 + 8 * c8) = s0; *(LAS f32x4*)(red + cr * 256 + 8 * c8 + 4) = s1;
        __syncthreads();
        if (tid < 256) { float t = 0.f;
#pragma unroll
            for (int q = 0; q < 16; ++q) t += red[q * 256 + tid];
            ((bf16_t*)(ws + WS_Y))[((size_t)b * SEQ + 4096) * FW + g * 256 + tid] = f2bf(t); }
        __syncthreads();
    }
    SchedChDft S{(const char*)(ws + WS_PT), (const char*)(ws + T_CS), G, bx};
    EpiChDft E{(bf16_t*)(ws + WS_Y)};
    g8::gemm_phase<EpiChDft, SchedChDft, SEQ, 512, false, 1, true>(lds, S, E);
}
__device__ __forceinline__ void ph_merge(const Params& p, LAS unsigned char* lds, int G, int bx) {
    unsigned char* ws = p.ws;
    SchedMerge2 S{(const char*)(ws + WS_Y), (const char*)(ws + WS_ATT), (const char*)(ws + WS_WFO), (const char*)(ws + WS_WAO), G, bx};
    EpiMergeBr E{EpiMerge{ws, (const bf16_t*)p.out}};
    g8::gemm_phase<EpiMergeBr, SchedMerge2, 1024, 1024, false, KREP_[4], false>(lds, S, E);
}
__device__ __forceinline__ void ph_outproj(const Params& p, LAS unsigned char* lds, int G, int bx) {
    unsigned char* ws = p.ws;
    typedef SchedGrid<M / 256, D / 256, D / 64, D, D> SG; SG S{(const char*)(ws + WS_MERGED), (const char*)(ws + WS_WOUT), G, bx};
    EpiX1 E{XIn{p.xp, p.xs}, ws};
    g8::gemm_phase<EpiX1, SG, D, D, false, KREP_[5]>(lds, S, E);
}
__device__ __forceinline__ void ph_up(const Params& p, LAS unsigned char* lds, int G, int bx, int vcu, int tid) {
    unsigned char* ws = p.ws;
    {
        const float* SSQ = (const float*)(ws + WS_SSQ); float* r2 = (float*)(ws + T_RSTD2);
        for (int r = vcu * NTHR + tid; r < M; r += G * NTHR) { const f32x4* q = (const f32x4*)(SSQ + (size_t)r * 32); float s = 0.f;
#pragma unroll
            for (int j = 0; j < 8; ++j) { const f32x4 v = q[j]; s += (v[0] + v[1]) + (v[2] + v[3]); }
            r2[r] = 1.f / (s * (1.f / D) + EPS); }
    }
    typedef SchedGrid<M / 256, DFF / 256, D / 64, D, D> SG; SG S{(const char*)(ws + WS_X1B), (const char*)(ws + WS_W1), G, bx};
    EpiRelu2 E{(bf16_t*)(ws + WS_U), (bf16_t*)p.out};
    g8::gemm_phase<EpiRelu2, SG, D, D, false, KREP_[6]>(lds, S, E);
}
__device__ __forceinline__ void ph_down(const Params& p, LAS unsigned char* lds, int G, int bx) {
    unsigned char* ws = p.ws;
    SchedDown S{(const char*)(ws + WS_U), (const char*)p.out, (const char*)(ws + WS_W2), G, bx};
    EpiDown E{p.out, ws, (unsigned*)(ws + WS_CTL) + CW_PANEL};
    g8::gemm_phase<EpiDown, SchedDown, 4096, DFF, false, KREP_[7]>(lds, S, E);
}

__global__ void __launch_bounds__(NTHR, 2) __attribute__((target("no-packed-fp32-ops"))) mk_fwd(Params p) {
    extern __shared__ __attribute__((aligned(16))) unsigned char lds_raw[];
    LAS unsigned char* lds = (LAS unsigned char*)lds_raw;
    const int tid = threadIdx.x, lane = tid & 63, wave = __builtin_amdgcn_readfirstlane(tid >> 6);
    const int G = gridDim.x, bx = blockIdx.x;
    const int vcu = (G % 8 == 0) ? (bx % 8) * (G / 8) + bx / 8 : bx;
    const int gw = vcu * NWAVES + wave, NGW = G * NWAVES;
    unsigned char* ws = p.ws;
    volatile LAS unsigned* MISC = (volatile LAS unsigned*)(lds + LDSCTL_OFF);
    if (tid < 64) MISC[tid] = 0u;
    __syncthreads();
    unsigned* ctl = (unsigned*)(ws + WS_CTL);
    XcdBarrier bar = xcd_barrier_post(ctl + CW_BAR + p.li * XCD_BAR_WORDS, MISC + 8);
    const int lo = p.ph_lo, hi = p.ph_hi;
#define IN(k) (lo <= (k) && (k) < hi)
#define SEAM(k) do { if (IN(k) && IN((k) + 1)) xcd_barrier(bar); } while (0)

#define PHASE(k, body) do { if (IN(k)) { body; } SEAM(k); } while (0)
    PHASE(0, p0_prologue(p, lds, gw, NGW, lane, wave));
    PHASE(1, ph_inproj(p, lds, G, bx));
    PHASE(2, { const bool fft_first = bx & 1;     if (!fft_first) natten_phase(p, lds, G, vcu, tid, lane, wave); fft_phase(p, lds, G, bx, tid, lane, wave); if (fft_first) natten_phase(p, lds, G, vcu, tid, lane, wave); });
    PHASE(3, ph_chdft(p, lds, G, bx, tid));
    PHASE(4, ph_merge(p, lds, G, bx));
    PHASE(5, ph_outproj(p, lds, G, bx));
    PHASE(6, ph_up(p, lds, G, bx, vcu, tid));
    PHASE(7, ph_down(p, lds, G, bx));
#ifdef MK_PROBE_SUBPHASES
    if (IN(8)) { fft_phase(p, lds, G, bx, tid, lane, wave); }
    if (IN(9)) { natten_phase(p, lds, G, bx, tid, lane, wave); }
#endif
#undef PHASE
#undef IN
#undef SEAM
}

extern "C" void kernel_launch(void* const* d_in, const int* in_sizes, int n_in, void* d_out, int out_size, void* d_ws, size_t ws_size, hipStream_t stream) {
    static int grid = 0;
    if (grid == 0) {
        if (n_in != 13 || ws_size < WS_END || out_size != M * D) { fprintf(stderr, "kernel_launch: unexpected sizes n_in %d ws %zu out %d\n", n_in, ws_size, out_size); grid = -1; return; }
        int dev = 0, cus = 0, per_cu = 0;
        if (hipGetDevice(&dev) != hipSuccess || hipDeviceGetAttribute(&cus, hipDeviceAttributeMultiprocessorCount, dev) != hipSuccess) { grid = -1; return; }
        if (hipFuncSetAttribute((const void*)mk_fwd, hipFuncAttributeMaxDynamicSharedMemorySize, LDS_BYTES) != hipSuccess) { fprintf(stderr, "kernel_launch: hipFuncSetAttribute failed\n"); grid = -1; return; }
        if (hipOccupancyMaxActiveBlocksPerMultiprocessor(&per_cu, (const void*)mk_fwd, NTHR, LDS_BYTES) != hipSuccess || per_cu < 1) fprintf(stderr, "kernel_launch: occupancy query says %d\n", per_cu);
        (void)hipGetLastError();
        grid = cus;
        if (grid != 256) { fprintf(stderr, "kernel_launch: built for a 256-CU device (MI355X), found %d CUs; nothing launched\n", cus); grid = -1; return; }
    }
    if (grid < 0) return;
    const float* xp = (const float*)d_in[0]; const float* xs = (const float*)d_in[1];
    const float* g_mix = (const float*)d_in[2]; const float* w_in = (const float*)d_in[3];
    const float* q_norm = (const float*)d_in[4]; const float* k_norm = (const float*)d_in[5]; const float* rpb = (const float*)d_in[6];
    const float* w_fo = (const float*)d_in[7]; const float* w_ao = (const float*)d_in[8]; const float* w_out = (const float*)d_in[9];
    const float* g_mlp = (const float*)d_in[10]; const float* w1 = (const float*)d_in[11]; const float* w2 = (const float*)d_in[12];
    unsigned char* ws = (unsigned char*)d_ws; float* out = (float*)d_out;

    hipMemsetAsync(ws + WS_CTL, 0, CTL_ZERO_BYTES, stream);
    Params prm{}; prm.xp = xp; prm.xs = xs; prm.g_mix = g_mix; prm.w_in = w_in; prm.q_norm = q_norm; prm.k_norm = k_norm; prm.rpb = rpb; prm.w_fo = w_fo; prm.w_ao = w_ao; prm.w_out = w_out;
    prm.g_mlp = g_mlp; prm.w1 = w1; prm.w2 = w2; prm.out = out; prm.ws = ws;
    int n_mk = 0;
#define MK(lo_, hi_) do { prm.ph_lo = lo_; prm.ph_hi = hi_; prm.li = n_mk++; hipLaunchKernelGGL(mk_fwd, dim3(grid), dim3(NTHR), LDS_BYTES, stream, prm); } while (0)
    constexpr int PLAN[][2] = {{0, 8}};
    for (auto& pl : PLAN) MK(pl[0], pl[1]);
}
```
